# Optimizing an MI355X kernel written in HIP

```python
import jax
import jax.numpy as jnp
from jax import lax
import numpy as np


D_MODEL = 1024
BATCH = 4
SEQ = 8192
DEPTH = 2

GRID_W = 64
CTX_LEN = 256
EPS = 1e-6
NEG_INF = -1e30

HEAD_DIM = 64
A_Q_HEADS = 8
A_KV_HEADS = 2
A_GROUP = A_Q_HEADS // A_KV_HEADS
B_Q_HEADS = 8
B_KV_HEADS = 2
B_GROUP = B_Q_HEADS // B_KV_HEADS
WINDOW = 128
Q_BLOCK = 128
BAND_SPAN = Q_BLOCK + 2 * WINDOW
ROPE_THETA = 10000.0
ROPE_PAIRS = HEAD_DIM // 4
A_QD = A_Q_HEADS * HEAD_DIM
A_KVD = A_KV_HEADS * HEAD_DIM
B_QD = B_Q_HEADS * HEAD_DIM
B_KVD = B_KV_HEADS * HEAD_DIM
ATTN_SPLITS = (A_QD, A_QD + A_KVD, A_QD + 2 * A_KVD, A_QD + 2 * A_KVD + B_QD, A_QD + 2 * A_KVD + B_QD + B_KVD)
ATTN_IN_DIM = A_QD + 2 * A_KVD + B_QD + 2 * B_KVD
ATTN_OUT_DIM = A_QD + B_QD

GLA_HEADS = 4
GLA_DK = D_MODEL // (2 * GLA_HEADS)
GLA_DV = D_MODEL // GLA_HEADS
GLA_KD = GLA_HEADS * GLA_DK
GLA_VD = GLA_HEADS * GLA_DV
GLA_RANK = 16
GLA_GATE_NORM = 16.0
GLA_CHUNK = 64
GLA_SPLITS = (GLA_KD, 2 * GLA_KD, 2 * GLA_KD + GLA_VD, 2 * GLA_KD + 2 * GLA_VD, 2 * GLA_KD + 2 * GLA_VD + GLA_RANK)
GLA_IN_DIM = 2 * GLA_KD + 2 * GLA_VD + 2 * GLA_RANK

PEER_HEADS = 8
PEER_N_KEYS = 128
PEER_N_EXPERTS = PEER_N_KEYS * PEER_N_KEYS
PEER_QUERY_DIM = 256
PEER_HALF = PEER_QUERY_DIM // 2
PEER_TOPK = 16
PEER_TOKEN_BLOCK = 128

N_EVEN = (DEPTH + 1) // 2
N_ODD = DEPTH // 2

kernel_name = 'hybrid_latent_dit_attn_gla_peer'


def rmsnorm(x, gain):
    x32 = x.astype(jnp.float32)
    y = x32 * lax.rsqrt(jnp.mean(x32 * x32, axis=-1, keepdims=True) + EPS)
    return (y * gain.astype(jnp.float32)).astype(x.dtype)


def adaln(cond, w, b):
    mod = jax.nn.silu(cond) @ w + b
    return jnp.split(mod[..., None, :], 6, axis=-1)


def axial_rope_tables(rows):
    row = jnp.repeat(jnp.arange(rows), GRID_W)
    col = jnp.tile(jnp.arange(GRID_W), rows)
    pos = jnp.stack([row, col], axis=-1).astype(jnp.float32)
    inv = ROPE_THETA ** (-jnp.arange(ROPE_PAIRS, dtype=jnp.float32) / ROPE_PAIRS)
    ang = pos[:, :, None] * inv
    return jnp.cos(ang), jnp.sin(ang)


def apply_rope(x, cos, sin):
    shape = x.shape
    xs = x.astype(jnp.float32).reshape(shape[:-1] + (2, 2, ROPE_PAIRS))
    bshape = (1, shape[1]) + (1,) * (len(shape) - 3) + (2, ROPE_PAIRS)
    cs, sn = cos.reshape(bshape), sin.reshape(bshape)
    x1, x2 = xs[..., 0, :], xs[..., 1, :]
    out = jnp.stack([x1 * cs - x2 * sn, x1 * sn + x2 * cs], axis=-2)
    return out.reshape(shape).astype(x.dtype)


def softmax_with_sink(s, sink):
    col = jnp.broadcast_to(sink.astype(jnp.float32)[None, :, :, None, None], s.shape[:-1] + (1,))
    return jax.nn.softmax(jnp.concatenate([s, col], axis=-1), axis=-1)[..., :-1]


def split_attn_projection(p):
    bsz, length, _ = p.shape
    qa, ka, va, qb, kb, vb = jnp.split(p, ATTN_SPLITS, axis=-1)
    return (qa.reshape(bsz, length, A_KV_HEADS, A_GROUP, HEAD_DIM),
            ka.reshape(bsz, length, A_KV_HEADS, HEAD_DIM),
            va.reshape(bsz, length, A_KV_HEADS, HEAD_DIM),
            qb.reshape(bsz, length, B_KV_HEADS, B_GROUP, HEAD_DIM),
            kb.reshape(bsz, length, B_KV_HEADS, HEAD_DIM),
            vb.reshape(bsz, length, B_KV_HEADS, HEAD_DIM))


def window_attention_latent(q, k, v, kc, vc, sink):
    bsz, length = q.shape[:2]
    n_blocks = length // Q_BLOCK
    pad = ((0, 0), (WINDOW, WINDOW), (0, 0), (0, 0))
    kp, vp = jnp.pad(k, pad), jnp.pad(v, pad)
    offs = jnp.arange(BAND_SPAN) - WINDOW
    band = jnp.abs(jnp.arange(Q_BLOCK)[:, None] - offs[None, :]) <= WINDOW
    ctx_ok = jnp.ones((Q_BLOCK, kc.shape[1]), dtype=bool)

    def block(n):
        start = n * Q_BLOCK
        qb = lax.dynamic_slice_in_dim(q, start, Q_BLOCK, axis=1)
        kb = jnp.concatenate([lax.dynamic_slice_in_dim(kp, start, BAND_SPAN, axis=1), kc], axis=1)
        vb = jnp.concatenate([lax.dynamic_slice_in_dim(vp, start, BAND_SPAN, axis=1), vc], axis=1)
        pos = start + offs
        valid = jnp.concatenate([band & ((pos >= 0) & (pos < length))[None, :], ctx_ok], axis=1)
        s = jnp.einsum('bqhgd,bkhd->bhgqk', qb, kb).astype(jnp.float32)
        p = softmax_with_sink(jnp.where(valid, s, NEG_INF), sink)
        return jnp.einsum('bhgqk,bkhd->bqhgd', p.astype(vb.dtype), vb)

    out = lax.map(block, jnp.arange(n_blocks))
    return jnp.moveaxis(out, 0, 1).reshape(bsz, length, -1)


def dense_attention_latent(q, k_all, v_all):
    bsz, length = q.shape[:2]

    def block(n):
        qb = lax.dynamic_slice_in_dim(q, n * Q_BLOCK, Q_BLOCK, axis=1)
        s = jnp.einsum('bqhgd,bkhd->bhgqk', qb, k_all).astype(jnp.float32)
        p = jax.nn.softmax(s, axis=-1)
        return jnp.einsum('bhgqk,bkhd->bqhgd', p.astype(v_all.dtype), v_all)

    out = lax.map(block, jnp.arange(length // Q_BLOCK))
    return jnp.moveaxis(out, 0, 1).reshape(bsz, length, -1)


def context_attention(q, k, v, sink):
    s = jnp.einsum('bqhgd,bkhd->bhgqk', q, k).astype(jnp.float32)
    p = jax.nn.softmax(s, axis=-1) if sink is None else softmax_with_sink(s, sink)
    o = jnp.einsum('bhgqk,bkhd->bqhgd', p.astype(v.dtype), v)
    return o.reshape(o.shape[0], o.shape[1], -1)


def attention_mixer(h_lat, h_ctx, w_in, w_out, sink, q_gain, k_gain, cos, sin, need_ctx):
    scale = HEAD_DIM ** -0.5
    qa, ka, va, qb, kb, vb = split_attn_projection(h_lat @ w_in)
    qa_c, ka_c, va_c, qb_c, kb_c, vb_c = split_attn_projection(h_ctx @ w_in)
    sink = sink.reshape(A_KV_HEADS, A_GROUP)
    qa = apply_rope(qa, cos, sin) * scale
    ka = apply_rope(ka, cos, sin)
    out_a = window_attention_latent(qa, ka, va, ka_c, va_c, sink)
    qb = apply_rope(rmsnorm(qb, q_gain), cos, sin) * scale
    kb = apply_rope(rmsnorm(kb, k_gain), cos, sin)
    kb_c = rmsnorm(kb_c, k_gain)
    out_b = dense_attention_latent(qb, jnp.concatenate([kb, kb_c], axis=1), jnp.concatenate([vb, vb_c], axis=1))
    y_lat = jnp.concatenate([out_a, out_b], axis=-1) @ w_out
    y_ctx = None
    if need_ctx:
        out_a_c = context_attention(qa_c * scale, ka_c, va_c, sink)
        out_b_c = context_attention(rmsnorm(qb_c, q_gain) * scale, kb_c, vb_c, None)
        y_ctx = jnp.concatenate([out_a_c, out_b_c], axis=-1) @ w_out
    return y_lat, y_ctx


def gla_project(h, w_in, gate_w, gate_b):
    bsz, length, _ = h.shape
    q, k, v, r, g_f, g_b = jnp.split(h @ w_in, GLA_SPLITS, axis=-1)

    def heads(t, d):
        return t.reshape(bsz, length, GLA_HEADS, d)

    def log_decay(g, i):
        return heads(jax.nn.log_sigmoid((g @ gate_w[i] + gate_b[i]).astype(jnp.float32)) / GLA_GATE_NORM, GLA_DK)

    return (heads(q, GLA_DK) * GLA_DK ** -0.5, heads(k, GLA_DK), heads(v, GLA_DV), heads(r, GLA_DV),
            log_decay(g_f, 0), log_decay(g_b, 1))


def gla_chunked(q, k, v, log_g, state0, with_output):
    bsz, length, nh, _ = q.shape
    dv = v.shape[-1]
    nc = length // GLA_CHUNK

    def to_chunks(t):
        return jnp.transpose(t.astype(jnp.float32).reshape(bsz, nc, GLA_CHUNK, nh, t.shape[-1]), (1, 0, 3, 2, 4))

    qc, kc, vc, gc = (to_chunks(t) for t in (q, k, v, log_g))
    b = jnp.cumsum(gc, axis=3)
    b_end = b[:, :, :, -1:, :]
    k_end = kc * jnp.exp(b_end - b)
    decay_end = jnp.exp(b[:, :, :, -1, :])
    if not with_output:
        def step_state(S, xs):
            ke, vv, de = xs
            return de[..., None] * S + jnp.einsum('bhcd,bhce->bhde', ke, vv), None
        s_fin, _ = lax.scan(step_state, state0, (k_end, vc, decay_end))
        return None, s_fin
    q_dec = qc * jnp.exp(b)

    def step(S, xs):
        qd, ke, vv, de = xs
        inter = jnp.einsum('bhcd,bhde->bhce', qd, S)
        return de[..., None] * S + jnp.einsum('bhcd,bhce->bhde', ke, vv), inter

    s_fin, inter = lax.scan(step, state0, (q_dec, k_end, vc, decay_end))
    lower = jnp.tril(jnp.ones((GLA_CHUNK, GLA_CHUNK), dtype=bool))
    att = jnp.einsum('nbhcd,nbhsd->nbhcs', q_dec, kc * jnp.exp(-b))
    intra = jnp.einsum('nbhcs,nbhse->nbhce', jnp.where(lower, att, 0.0), vc)
    out = jnp.transpose(inter + intra, (1, 0, 3, 2, 4)).reshape(bsz, length, nh, dv)
    return out.astype(v.dtype), s_fin


def gla_mixer(h_lat, h_ctx, w_in, gate_w, gate_b, head_gain, w_out, need_ctx):
    bsz = h_lat.shape[0]
    ql, kl, vl, rl, gfl, gbl = gla_project(h_lat, w_in, gate_w, gate_b)
    qc, kc, vc, rc, gfc, gbc = gla_project(h_ctx, w_in, gate_w, gate_b)
    s0 = jnp.zeros((bsz, GLA_HEADS, GLA_DK, GLA_DV), jnp.float32)

    def rev(t):
        return jnp.flip(t, axis=1)

    o_cf, s_f = gla_chunked(qc, kc, vc, gfc, s0, need_ctx)
    o_cb, s_b = gla_chunked(rev(qc), rev(kc), rev(vc), rev(gbc), s0, need_ctx)
    o_lf, _ = gla_chunked(ql, kl, vl, gfl, s_f, True)
    o_lb, _ = gla_chunked(rev(ql), rev(kl), rev(vl), rev(gbl), s_b, True)

    def finish(o, r):
        y = rmsnorm(o, head_gain) * jax.nn.silu(r)
        return y.reshape(bsz, y.shape[1], GLA_VD) @ w_out

    y_lat = finish(o_lf + rev(o_lb), rl)
    y_ctx = finish(o_cf + rev(o_cb), rc) if need_ctx else None
    return y_lat, y_ctx


def peer_ffn(h, w_query, sub_keys, u, v):
    shape = h.shape
    t = h.reshape(-1, shape[-1])
    n_tok = t.shape[0]
    q = (t @ w_query).reshape(n_tok, PEER_HEADS, 2, PEER_HALF)
    s = jnp.einsum('thpd,hpnd->thpn', q, sub_keys).astype(jnp.float32)
    s_top, i_top = lax.top_k(s, PEER_TOPK)
    cand_s = (s_top[:, :, 0, :, None] + s_top[:, :, 1, None, :]).reshape(n_tok, PEER_HEADS, PEER_TOPK * PEER_TOPK)
    cand_i = (i_top[:, :, 0, :, None] * PEER_N_KEYS + i_top[:, :, 1, None, :]).reshape(n_tok, PEER_HEADS, PEER_TOPK * PEER_TOPK)
    best_s, best_pos = lax.top_k(cand_s, PEER_TOPK)
    experts = jnp.take_along_axis(cand_i, best_pos, axis=-1)
    gates = jax.nn.softmax(best_s, axis=-1).astype(h.dtype)
    nb = n_tok // PEER_TOKEN_BLOCK

    def block(args):
        tb, eb, gb = args
        act = jax.nn.gelu(jnp.einsum('td,thkd->thk', tb, jnp.take(u, eb, axis=0)), approximate=False)
        return jnp.einsum('thk,thkd->td', gb * act, jnp.take(v, eb, axis=0))

    out = lax.map(block, (t.reshape(nb, PEER_TOKEN_BLOCK, shape[-1]),
                          experts.reshape(nb, PEER_TOKEN_BLOCK, PEER_HEADS, PEER_TOPK),
                          gates.reshape(nb, PEER_TOKEN_BLOCK, PEER_HEADS, PEER_TOPK)))
    return out.reshape(shape)


def setup_inputs(seed: int = 0) -> dict:
    key = jax.random.key(seed)
    ks = jax.random.split(key, 23)

    def nrm(k, shape, scale):
        return scale * jax.random.normal(k, shape, jnp.float32)

    def gain(k, shape):
        return 1.0 + 0.02 * jax.random.normal(k, shape, jnp.float32)

    return {
        'x': nrm(ks[0], (BATCH, SEQ, D_MODEL), 1.0),
        'c': nrm(ks[1], (BATCH, D_MODEL), 1.0),
        'ctx': nrm(ks[2], (BATCH, CTX_LEN, D_MODEL), 1.0),
        'c_ctx': nrm(ks[3], (D_MODEL,), 1.0),
        'ada_w': nrm(ks[4], (DEPTH, D_MODEL, 6 * D_MODEL), 0.5 * D_MODEL ** -0.5),
        'ada_b': nrm(ks[5], (DEPTH, 6 * D_MODEL), 0.02),
        'norm_mix': gain(ks[6], (DEPTH, D_MODEL)),
        'norm_ffn': gain(ks[7], (DEPTH, D_MODEL)),
        'attn_w_in': nrm(ks[8], (N_EVEN, D_MODEL, ATTN_IN_DIM), D_MODEL ** -0.5),
        'attn_sink': nrm(ks[9], (N_EVEN, A_Q_HEADS), 1.0),
        'attn_q_gain': gain(ks[10], (N_EVEN, HEAD_DIM)),
        'attn_k_gain': gain(ks[11], (N_EVEN, HEAD_DIM)),
        'attn_w_out': nrm(ks[12], (N_EVEN, ATTN_OUT_DIM, D_MODEL), ATTN_OUT_DIM ** -0.5),
        'gla_w_in': nrm(ks[13], (N_ODD, D_MODEL, GLA_IN_DIM), D_MODEL ** -0.5),
        'gla_gate_w': nrm(ks[14], (N_ODD, 2, GLA_RANK, GLA_KD), GLA_RANK ** -0.5),
        'gla_gate_b': nrm(ks[15], (N_ODD, 2, GLA_KD), 0.1),
        'gla_head_gain': gain(ks[16], (N_ODD, GLA_DV)),
        'gla_w_out': nrm(ks[17], (N_ODD, GLA_VD, D_MODEL), GLA_VD ** -0.5),
        'peer_wq': nrm(ks[18], (DEPTH, D_MODEL, PEER_HEADS * PEER_QUERY_DIM), D_MODEL ** -0.5),
        'peer_keys': nrm(ks[19], (DEPTH, PEER_HEADS, 2, PEER_N_KEYS, PEER_HALF), PEER_HALF ** -0.5),
        'peer_u': nrm(ks[20], (DEPTH, PEER_N_EXPERTS, D_MODEL), D_MODEL ** -0.5),
        'peer_v': nrm(ks[21], (DEPTH, PEER_N_EXPERTS, D_MODEL), 1.0),
        'final_norm': gain(ks[22], (D_MODEL,)),
    }


def reference(x, c, ctx, c_ctx, ada_w, ada_b, norm_mix, norm_ffn, attn_w_in, attn_sink, attn_q_gain,
              attn_k_gain, attn_w_out, gla_w_in, gla_gate_w, gla_gate_b, gla_head_gain, gla_w_out,
              peer_wq, peer_keys, peer_u, peer_v, final_norm):
    length = x.shape[1]
    rows = length // GRID_W
    cos, sin = axial_rope_tables(rows)
    x_lat, x_ctx = x, ctx
    for layer in range(DEPTH):
        need_ctx = layer < DEPTH - 1
        sh1, sc1, g1, sh2, sc2, g2 = adaln(c, ada_w[layer], ada_b[layer])
        csh1, csc1, cg1, csh2, csc2, cg2 = adaln(c_ctx[None], ada_w[layer], ada_b[layer])
        h_lat = rmsnorm(x_lat, norm_mix[layer]) * (1.0 + sc1) + sh1
        h_ctx = rmsnorm(x_ctx, norm_mix[layer]) * (1.0 + csc1) + csh1
        j = layer // 2
        if layer % 2 == 0:
            y_lat, y_ctx = attention_mixer(h_lat, h_ctx, attn_w_in[j], attn_w_out[j], attn_sink[j],
                                           attn_q_gain[j], attn_k_gain[j], cos, sin, need_ctx)
        else:
            y_lat, y_ctx = gla_mixer(h_lat, h_ctx, gla_w_in[j], gla_gate_w[j], gla_gate_b[j],
                                     gla_head_gain[j], gla_w_out[j], need_ctx)
        x_lat = x_lat + g1 * y_lat
        f_lat = rmsnorm(x_lat, norm_ffn[layer]) * (1.0 + sc2) + sh2
        x_lat = x_lat + g2 * peer_ffn(f_lat, peer_wq[layer], peer_keys[layer], peer_u[layer], peer_v[layer])
        if need_ctx:
            x_ctx = x_ctx + cg1 * y_ctx
            f_ctx = rmsnorm(x_ctx, norm_ffn[layer]) * (1.0 + csc2) + csh2
            x_ctx = x_ctx + cg2 * peer_ffn(f_ctx, peer_wq[layer], peer_keys[layer], peer_u[layer], peer_v[layer])
    return rmsnorm(x_lat, final_norm)
```

```cpp
#include <hip/hip_runtime.h>
#include <hip/hip_cooperative_groups.h>
#include <cstdio>
#include <cstdint>
namespace cg = cooperative_groups;

#ifndef MULTI_LAUNCH
#define MULTI_LAUNCH 1
#endif

#define DEVINL __device__ __forceinline__
typedef unsigned short bf16_t;
typedef short bf16x8 __attribute__((ext_vector_type(8)));
typedef float f32x4 __attribute__((ext_vector_type(4)));
typedef unsigned u32x4 __attribute__((ext_vector_type(4)));
typedef unsigned u32x2 __attribute__((ext_vector_type(2)));

constexpr int NB = 4, SEQ = 8192, DM = 1024, CTX = 256;
constexpr int TLAT = NB * SEQ;
constexpr int TCTX = NB * CTX;
constexpr int TALL = TLAT + TCTX;
constexpr int KVR = SEQ + CTX;
constexpr int NTHREADS = 512, NWAVES = 8;
constexpr float EPS = 1e-6f;
constexpr float LOG2E = 1.4426950408889634f;
constexpr float QSCALE = 0.125f * LOG2E;
constexpr int ATTN_IN = 1536, GLA_IN = 3104, GLA_IN_PAD = 3328;
constexpr int LDS_BYTES = 80 * 1024;
constexpr int NPHASES = 19;

constexpr size_t MiB = 1u << 20;
constexpr size_t WS_MOD = 1 * MiB;
constexpr size_t WS_WT_ATTN_IN = 2 * MiB;
constexpr size_t WS_WT_ATTN_OUT = 5 * MiB;
constexpr size_t WS_WT_GLA_IN = 7 * MiB;
constexpr size_t WS_WT_GLA_OUT = 14 * MiB;
constexpr size_t WS_WT_PQ0 = 16 * MiB;
constexpr size_t WS_WT_PQ1 = 20 * MiB;
constexpr size_t WS_KEYS = 24 * MiB;
constexpr size_t WS_DEND = 25 * MiB;
constexpr size_t WS_G = 28 * MiB;
constexpr size_t WS_XR = 34 * MiB;
constexpr size_t WS_R1 = 166 * MiB;
constexpr size_t WS_R2 = 232 * MiB;
constexpr size_t WS_R3 = 298 * MiB;
constexpr size_t WS_R4 = 364 * MiB;
constexpr size_t WS_END = 496 * MiB;
constexpr size_t SZ_HALF_R = 33 * MiB;

struct Params {
    const float* in[23];
    float* out;
    unsigned char* ws;
};

DEVINL float bf2f(unsigned v) { return __uint_as_float(v << 16); }
DEVINL unsigned f2bf(float f) { unsigned u = __float_as_uint(f); return (u + 0x7fffu + ((u >> 16) & 1u)) >> 16; }
DEVINL unsigned pk2(float lo, float hi) { return f2bf(lo) | (f2bf(hi) << 16); }
DEVINL float wave_sum(float v) {
#pragma unroll
    for (int o = 1; o < 64; o <<= 1) v += __shfl_xor(v, o);
    return v;
}
DEVINL float silu_f(float x) { return x / (1.f + __expf(-x)); }
DEVINL float gelu_f(float x) { return 0.5f * x * (1.f + erff(x * 0.70710678118654752f)); }
DEVINL float logsig_f(float x) { return fminf(x, 0.f) - log1pf(__expf(-fabsf(x))); }
DEVINL void unpack8(const u32x4 v, float* f) {
    f[0] = __uint_as_float(v.x << 16); f[1] = __uint_as_float(v.x & 0xffff0000u);
    f[2] = __uint_as_float(v.y << 16); f[3] = __uint_as_float(v.y & 0xffff0000u);
    f[4] = __uint_as_float(v.z << 16); f[5] = __uint_as_float(v.z & 0xffff0000u);
    f[6] = __uint_as_float(v.w << 16); f[7] = __uint_as_float(v.w & 0xffff0000u);
}
DEVINL int row_bb(int r) { return r < TLAT ? (r >> 13) : 4; }
DEVINL const float* mod_ptr(const Params& p, int l, int bb, int which) { return (const float*)(p.ws + WS_MOD) + ((size_t)((l * 5 + bb) * 6 + which)) * 1024; }

DEVINL void transpose_item(const float* W, int K, int N, int Npad, bf16_t* WT, int item, float* tile  ) {
    const int nt = Npad / 64, kb = item / nt, nb = item % nt, k0 = kb * 64, n0 = nb * 64, tid = threadIdx.x;
    {
        const int nn = tid & 63, kq = tid >> 6;
#pragma unroll
        for (int i = 0; i < 8; ++i) { const int kk = kq + 8 * i; const int n = n0 + nn; tile[kk * 65 + nn] = (n < N) ? W[(size_t)(k0 + kk) * N + n] : 0.f; }
    }
    __syncthreads();
    {
        const int c = tid & 7, nn = tid >> 3;
        const float* s = tile + (8 * c) * 65 + nn;
        u32x4 o; o.x = pk2(s[0], s[65]); o.y = pk2(s[2 * 65], s[3 * 65]); o.z = pk2(s[4 * 65], s[5 * 65]); o.w = pk2(s[6 * 65], s[7 * 65]);
        *(u32x4*)(WT + (size_t)(n0 + nn) * K + k0 + 8 * c) = o;
    }
    __syncthreads();
}
DEVINL void phase_prologue(const Params& p, char* smem) {
    const int tid = threadIdx.x, lane = tid & 63, wid = tid >> 6;
    constexpr int I_MOD = 24;
    constexpr int I_T0 = 16 * 24, I_T1 = 16 * 16, I_T2 = 16 * 52, I_T3 = 16 * 16, I_T4 = 16 * 32, I_T5 = 16 * 32;
    constexpr int I_KEYS = 128;
    constexpr int NITEMS = I_MOD + I_T0 + I_T1 + I_T2 + I_T3 + I_T4 + I_T5 + I_KEYS;
    for (int it = blockIdx.x; it < NITEMS; it += gridDim.x) {
        int r = it;
        if (r < I_MOD) {
            const int wt = r * 8 + wid, l = wt / 96, n0 = (wt % 96) * 64;
            const float* W = p.in[4] + (size_t)l * 1024 * 6144 + n0 + lane;
            const float* c = p.in[1]; const float* cc = p.in[3];
            float a0 = 0.f, a1 = 0.f, a2 = 0.f, a3 = 0.f, a4 = 0.f;
#pragma unroll 8
            for (int k = 0; k < 1024; ++k) {
                const float w = W[(size_t)k * 6144];
                a0 += silu_f(c[k]) * w; a1 += silu_f(c[1024 + k]) * w; a2 += silu_f(c[2048 + k]) * w; a3 += silu_f(c[3072 + k]) * w; a4 += silu_f(cc[k]) * w;
            }
            const float bias = p.in[5][l * 6144 + n0 + lane];
            float* M = (float*)(p.ws + WS_MOD) + (size_t)l * 5 * 6144 + n0 + lane;
            M[0] = a0 + bias; M[6144] = a1 + bias; M[2 * 6144] = a2 + bias; M[3 * 6144] = a3 + bias; M[4 * 6144] = a4 + bias;
            continue;
        }
        r -= I_MOD;
        float* tile = (float*)smem;
        if (r < I_T0) { transpose_item(p.in[8], 1024, 1536, 1536, (bf16_t*)(p.ws + WS_WT_ATTN_IN), r, tile); continue; } r -= I_T0;
        if (r < I_T1) { transpose_item(p.in[12], 1024, 1024, 1024, (bf16_t*)(p.ws + WS_WT_ATTN_OUT), r, tile); continue; } r -= I_T1;
        if (r < I_T2) { transpose_item(p.in[13], 1024, GLA_IN, GLA_IN_PAD, (bf16_t*)(p.ws + WS_WT_GLA_IN), r, tile); continue; } r -= I_T2;
        if (r < I_T3) { transpose_item(p.in[17], 1024, 1024, 1024, (bf16_t*)(p.ws + WS_WT_GLA_OUT), r, tile); continue; } r -= I_T3;
        if (r < I_T4) { transpose_item(p.in[18], 1024, 2048, 2048, (bf16_t*)(p.ws + WS_WT_PQ0), r, tile); continue; } r -= I_T4;
        if (r < I_T5) { transpose_item(p.in[18] + (size_t)1024 * 2048, 1024, 2048, 2048, (bf16_t*)(p.ws + WS_WT_PQ1), r, tile); continue; } r -= I_T5;
        {
            const size_t e0 = ((size_t)r * 512 + tid) * 8;
            const f32x4 a = *(const f32x4*)(p.in[19] + e0), b = *(const f32x4*)(p.in[19] + e0 + 4);
            u32x4 o; o.x = pk2(a.x, a.y); o.y = pk2(a.z, a.w); o.z = pk2(b.x, b.y); o.w = pk2(b.z, b.w);
            *(u32x4*)((bf16_t*)(p.ws + WS_KEYS) + e0) = o;
        }
    }
}

DEVINL void phase_norm_mod(const Params& p, const float* src_lat, const float* src_ctx, int nrows, const float* gain, int layer, int w_sh, int w_sc, bf16_t* dst) {
    const int lane = threadIdx.x & 63, gw = blockIdx.x * NWAVES + (threadIdx.x >> 6), ngw = gridDim.x * NWAVES;
    for (int row = gw; row < nrows; row += ngw) {
        const float* xr = row < TLAT ? src_lat + (size_t)row * DM : src_ctx + (size_t)(row - TLAT) * DM;
        const int bb = row_bb(row);
        const float* sh = mod_ptr(p, layer, bb, w_sh); const float* sc = mod_ptr(p, layer, bb, w_sc);
        f32x4 v[4]; float ss = 0.f;
#pragma unroll
        for (int j = 0; j < 4; ++j) { v[j] = *(const f32x4*)(xr + (j * 64 + lane) * 4); ss += (v[j].x * v[j].x + v[j].y * v[j].y) + (v[j].z * v[j].z + v[j].w * v[j].w); }
        const float rinv = rsqrtf(wave_sum(ss) * (1.f / DM) + EPS);
#pragma unroll
        for (int j = 0; j < 4; ++j) {
            const int c = (j * 64 + lane) * 4;
            const f32x4 g = *(const f32x4*)(gain + c), s1 = *(const f32x4*)(sc + c), s0 = *(const f32x4*)(sh + c);
            u32x2 o;
            o.x = pk2(v[j].x * rinv * g.x * (1.f + s1.x) + s0.x, v[j].y * rinv * g.y * (1.f + s1.y) + s0.y);
            o.y = pk2(v[j].z * rinv * g.z * (1.f + s1.z) + s0.z, v[j].w * rinv * g.w * (1.f + s1.w) + s0.w);
            *(u32x2*)(dst + (size_t)row * DM + c) = o;
        }
    }
}

DEVINL void convert_flat(const float* src, bf16_t* dst, size_t n) {
    const size_t nth = (size_t)gridDim.x * NTHREADS;
    for (size_t i = (size_t)blockIdx.x * NTHREADS + threadIdx.x; i < n / 8; i += nth) {
        const f32x4 a = *(const f32x4*)(src + i * 8), b = *(const f32x4*)(src + i * 8 + 4);
        u32x4 o; o.x = pk2(a.x, a.y); o.y = pk2(a.z, a.w); o.z = pk2(b.x, b.y); o.w = pk2(b.z, b.w);
        *(u32x4*)(dst + i * 8) = o;
    }
}

constexpr int G_BM = 128, G_BN = 128, G_BK = 64, G_LS = G_BK + 8;
template <class Epi>
DEVINL void gemm_simple(const bf16_t* A, const bf16_t* Bt, int M, int N, int K, char* smem, const Epi& epi) {
    bf16_t* sA = (bf16_t*)smem; bf16_t* sB = sA + G_BM * G_LS;
    const int tid = threadIdx.x, lane = tid & 63, wid = tid >> 6, wm = wid >> 2, wn = wid & 3, l15 = lane & 15, lq = lane >> 4;
    const int nTM = M / G_BM, nTN = N / G_BN;
    for (int tile = blockIdx.x; tile < nTM * nTN; tile += gridDim.x) {
        const int tm = tile / nTN, tn = tile % nTN;
        f32x4 acc[4][2];
#pragma unroll
        for (int a = 0; a < 4; ++a)
#pragma unroll
            for (int b = 0; b < 2; ++b) acc[a][b] = (f32x4){0.f, 0.f, 0.f, 0.f};
        for (int k0 = 0; k0 < K; k0 += G_BK) {
#pragma unroll
            for (int i = 0; i < 2; ++i) {
                const int ch = tid + i * NTHREADS, row = ch >> 3, c8 = ch & 7;
                const u32x4 va = *(const u32x4*)(A + (size_t)(tm * G_BM + row) * K + k0 + c8 * 8);
                const u32x4 vb = *(const u32x4*)(Bt + (size_t)(tn * G_BN + row) * K + k0 + c8 * 8);
                *(u32x4*)(sA + row * G_LS + c8 * 8) = va;
                *(u32x4*)(sB + row * G_LS + c8 * 8) = vb;
            }
            __syncthreads();
#pragma unroll
            for (int kk = 0; kk < 2; ++kk) {
                bf16x8 af[4], bfr[2];
#pragma unroll
                for (int mi = 0; mi < 4; ++mi) af[mi] = *(const bf16x8*)(sA + (wm * 64 + mi * 16 + l15) * G_LS + kk * 32 + lq * 8);
#pragma unroll
                for (int ni = 0; ni < 2; ++ni) bfr[ni] = *(const bf16x8*)(sB + (wn * 32 + ni * 16 + l15) * G_LS + kk * 32 + lq * 8);
#pragma unroll
                for (int mi = 0; mi < 4; ++mi)
#pragma unroll
                    for (int ni = 0; ni < 2; ++ni) acc[mi][ni] = __builtin_amdgcn_mfma_f32_16x16x32_bf16(bfr[ni], af[mi], acc[mi][ni], 0, 0, 0);
            }
            __syncthreads();
        }
#pragma unroll
        for (int mi = 0; mi < 4; ++mi)
#pragma unroll
            for (int ni = 0; ni < 2; ++ni) epi(tm * G_BM + wm * 64 + mi * 16 + l15, tn * G_BN + wn * 32 + ni * 16 + lq * 4, acc[mi][ni]);
    }
}
struct EpiBf16 {
    bf16_t* C; int ldc;
    DEVINL void operator()(int row, int col, const f32x4 v) const { u32x2 o; o.x = pk2(v.x, v.y); o.y = pk2(v.z, v.w); *(u32x2*)(C + (size_t)row * ldc + col) = o; }
};
struct EpiResid {
    const float* xin_lat; const float* xin_ctx; float* XR; const float* gate_base;
    DEVINL void operator()(int row, int col, const f32x4 v) const {
        const float* xi = row < TLAT ? xin_lat + (size_t)row * DM + col : xin_ctx + (size_t)(row - TLAT) * DM + col;
        const f32x4 x = *(const f32x4*)xi, g = *(const f32x4*)(gate_base + (size_t)row_bb(row) * 6 * 1024 + col);
        *(f32x4*)(XR + (size_t)row * DM + col) = x + g * v;
    }
};
struct EpiGla {
    bf16_t* QK; bf16_t* VR; float* G;
    DEVINL void operator()(int row, int col, const f32x4 v) const {
        if (col < 1024) { u32x2 o; o.x = pk2(v.x, v.y); o.y = pk2(v.z, v.w); *(u32x2*)(QK + (size_t)row * 1024 + col) = o; }
        else if (col < 3072) { u32x2 o; o.x = pk2(v.x, v.y); o.y = pk2(v.z, v.w); *(u32x2*)(VR + (size_t)row * 2048 + (col - 1024)) = o; }
        else if (col < GLA_IN) { *(f32x4*)(G + (size_t)row * 32 + (col - 3072)) = v; }
    }
};

DEVINL void phase_qkpost(const Params& p) {
    const int lane = threadIdx.x & 63, gw = blockIdx.x * NWAVES + (threadIdx.x >> 6), ngw = gridDim.x * NWAVES;
    const bf16_t* P0 = (const bf16_t*)(p.ws + WS_R4);
    bf16_t* Q = (bf16_t*)(p.ws + WS_R2);
    bf16_t* KA = (bf16_t*)(p.ws + WS_R3); bf16_t* VA = KA + (size_t)NB * KVR * 128; bf16_t* KB = VA + (size_t)NB * KVR * 128; bf16_t* VB = KB + (size_t)NB * KVR * 128;
    const float qg = p.in[10][lane], kg = p.in[11][lane];
    const int pr = lane & 15, ax = lane >> 5, hf = (lane >> 4) & 1;
    const float inv = exp2f(-(float)pr * (13.287712379549449f / 16.f));
    for (int row = gw; row < TALL; row += ngw) {
        const bool lat = row < TLAT;
        float cs = 1.f, sn = 0.f; size_t kvrow;
        if (lat) { const int b = row >> 13, t = row & 8191; const float pos = (float)(ax ? (t & 63) : (t >> 6)); sincosf(pos * inv, &sn, &cs); kvrow = (size_t)b * KVR + CTX + t; }
        else { const int rc = row - TLAT, b = rc >> 8, j = rc & 255; kvrow = (size_t)b * KVR + j; }
        const bf16_t* pr0 = P0 + (size_t)row * ATTN_IN + lane;
#pragma unroll 4
        for (int slot = 0; slot < 24; ++slot) {
            float v = bf2f(pr0[slot * 64]);
            const bool isq = (slot < 8) || (slot >= 12 && slot < 20);
            const bool isv = (slot == 10 || slot == 11 || slot >= 22);
            const bool isB = slot >= 12;
            if (isB && !isv) { const float ss = wave_sum(v * v) * (1.f / 64.f); v = v * rsqrtf(ss + EPS) * (isq ? qg : kg); }
            if (!isv) { const float pt = __shfl_xor(v, 16); v = hf ? (pt * sn + v * cs) : (v * cs - pt * sn); }
            if (isq) v *= QSCALE;
            const bf16_t o = (bf16_t)f2bf(v);
            if (slot < 8) Q[(size_t)row * 1024 + slot * 64 + lane] = o;
            else if (slot < 10) KA[kvrow * 128 + (slot - 8) * 64 + lane] = o;
            else if (slot < 12) VA[kvrow * 128 + (slot - 10) * 64 + lane] = o;
            else if (slot < 20) Q[(size_t)row * 1024 + 512 + (slot - 12) * 64 + lane] = o;
            else if (slot < 22) KB[kvrow * 128 + (slot - 20) * 64 + lane] = o;
            else VB[kvrow * 128 + (slot - 22) * 64 + lane] = o;
        }
    }
}

DEVINL void phase_attn_naive(const Params& p, char* smem) {
    float* sK = (float*)smem; float* sV = sK + 32 * 64;
    const int tid = threadIdx.x, g = tid >> 7, qi = tid & 127;
    const bf16_t* Q = (const bf16_t*)(p.ws + WS_R2);
    const bf16_t* KA = (const bf16_t*)(p.ws + WS_R3); const bf16_t* VA = KA + (size_t)NB * KVR * 128; const bf16_t* KB = VA + (size_t)NB * KVR * 128; const bf16_t* VB = KB + (size_t)NB * KVR * 128;
    bf16_t* O = (bf16_t*)(p.ws + WS_R4);
    constexpr int NU_B = 512, NU_A = 512, NU_C = 32;
    for (int u = blockIdx.x; u < NU_B + NU_A + NU_C; u += gridDim.x) {
        int typeB, b, kvh, q0, isctx;
        if (u < NU_B) { typeB = 1; isctx = 0; b = u >> 7; kvh = (u >> 6) & 1; q0 = (u & 63) * 128; }
        else if (u < NU_B + NU_A) { const int v = u - NU_B; typeB = 0; isctx = 0; b = v >> 7; kvh = (v >> 6) & 1; q0 = (v & 63) * 128; }
        else { const int v = u - NU_B - NU_A; typeB = v >> 4; isctx = 1; b = (v >> 2) & 3; kvh = (v >> 1) & 1; q0 = (v & 1) * 128; }
        const int qpos = q0 + qi;
        const size_t qrow = isctx ? (size_t)TLAT + b * CTX + qpos : (size_t)b * SEQ + qpos;
        const int hq = kvh * 4 + g, hcol = (typeB ? 512 : 0) + hq * 64;
        const bf16_t* Kp = (typeB ? KB : KA) + (size_t)b * KVR * 128 + kvh * 64;
        const bf16_t* Vp = (typeB ? VB : VA) + (size_t)b * KVR * 128 + kvh * 64;
        float q[64], o[64];
#pragma unroll
        for (int c = 0; c < 8; ++c) { const u32x4 v = *(const u32x4*)(Q + qrow * 1024 + hcol + c * 8); unpack8(v, q + c * 8); }
#pragma unroll
        for (int d = 0; d < 64; ++d) o[d] = 0.f;
        float m = -1e30f, l = 0.f;
        int lo = 0, hi = 0;
        if (!isctx) { if (typeB) { lo = 0; hi = SEQ; } else { lo = q0 - 128 < 0 ? 0 : q0 - 128; hi = q0 + 256 > SEQ ? SEQ : q0 + 256; } }
        const int ntile = 8 + (hi - lo) / 32;
        for (int t = 0; t < ntile; ++t) {
            const int kv0 = t < 8 ? t * 32 : CTX + lo + (t - 8) * 32;
            __syncthreads();
            {
                const int kr = tid >> 4, c4 = (tid & 15) * 4;
                const u32x2 kk = *(const u32x2*)(Kp + (size_t)(kv0 + kr) * 128 + c4), vv = *(const u32x2*)(Vp + (size_t)(kv0 + kr) * 128 + c4);
                *(f32x4*)(sK + kr * 64 + c4) = (f32x4){__uint_as_float(kk.x << 16), __uint_as_float(kk.x & 0xffff0000u), __uint_as_float(kk.y << 16), __uint_as_float(kk.y & 0xffff0000u)};
                *(f32x4*)(sV + kr * 64 + c4) = (f32x4){__uint_as_float(vv.x << 16), __uint_as_float(vv.x & 0xffff0000u), __uint_as_float(vv.y << 16), __uint_as_float(vv.y & 0xffff0000u)};
            }
            __syncthreads();
            const bool band = (!typeB) && (t >= 8);
            const int kpos0 = lo + (t - 8) * 32;
#pragma unroll 1
            for (int j = 0; j < 32; ++j) {
                float a = 0.f;
#pragma unroll
                for (int d = 0; d < 64; d += 4) { const f32x4 kq = *(const f32x4*)(sK + j * 64 + d); a += q[d] * kq.x + q[d + 1] * kq.y + q[d + 2] * kq.z + q[d + 3] * kq.w; }
                bool valid = true;
                if (band) { const int dd = qpos - (kpos0 + j); valid = (dd <= 128) && (dd >= -128); }
                if (valid) {
                    if (a > m) {
                        const float alpha = exp2f(m - a); l *= alpha; m = a;
#pragma unroll
                        for (int d = 0; d < 64; ++d) o[d] *= alpha;
                    }
                    const float pj = exp2f(a - m); l += pj;
#pragma unroll
                    for (int d = 0; d < 64; d += 4) { const f32x4 vq = *(const f32x4*)(sV + j * 64 + d); o[d] += pj * vq.x; o[d + 1] += pj * vq.y; o[d + 2] += pj * vq.z; o[d + 3] += pj * vq.w; }
                }
            }
        }
        if (!typeB) l += exp2f(p.in[9][hq] * LOG2E - m);
        const float rl = 1.f / l;
#pragma unroll
        for (int c = 0; c < 8; ++c) {
            u32x4 w; w.x = pk2(o[c * 8] * rl, o[c * 8 + 1] * rl); w.y = pk2(o[c * 8 + 2] * rl, o[c * 8 + 3] * rl); w.z = pk2(o[c * 8 + 4] * rl, o[c * 8 + 5] * rl); w.w = pk2(o[c * 8 + 6] * rl, o[c * 8 + 7] * rl);
            *(u32x4*)(O + qrow * 1024 + hcol + c * 8) = w;
        }
    }
}

__device__ const unsigned char PAIR_A[52] = {0,0,0,0,0,0,0,0,0,0,0,0,0,0,0,0, 1,1,1,1,1,1,1,1, 2,2,2,2,2, 3,3,3,3, 4,4,4, 5,5, 6,6, 7,7, 8,9,10,11,12,13,14,15, 0,0};
__device__ const unsigned char PAIR_B[52] = {0,1,2,3,4,5,6,7,8,9,10,11,12,13,14,15, 0,1,2,3,4,5,6,7, 0,1,2,3,4, 0,1,2,3, 0,1,2, 0,1, 0,1, 0,1, 0,0,0,0,0,0,0,0, 0,0};
DEVINL int f2sort(float f) { int s = __float_as_int(f); return s ^ ((s >> 31) & 0x7fffffff); }
DEVINL float sort2f(int s) { return __int_as_float(s ^ ((s >> 31) & 0x7fffffff)); }
DEVINL void phase_topk(const Params& p, int layer, int nrows, char* smem) {
    const int tid = threadIdx.x, lane = tid & 63, wid = tid >> 6, l15 = lane & 15, lq = lane >> 4;
    int* scr = (int*)smem + wid * 512;
    const bf16_t* Qp = (const bf16_t*)(p.ws + WS_R4);
    const bf16_t* keys = (const bf16_t*)(p.ws + WS_KEYS) + (size_t)layer * 8 * 2 * 128 * 128;
    int* EX = (int*)(p.ws + WS_R2); float* GT = (float*)(p.ws + WS_R2 + (size_t)TALL * 128 * 4);
    const int ntask = (nrows / 16) * 8, gw = blockIdx.x * NWAVES + wid, ngw = gridDim.x * NWAVES;
    for (int task = gw; task < ntask; task += ngw) {
        const int h = task & 7, tok0 = (task >> 3) * 16;
#pragma unroll 1
        for (int ph = 0; ph < 2; ++ph) {
            f32x4 acc[8];
#pragma unroll
            for (int i = 0; i < 8; ++i) acc[i] = (f32x4){0.f, 0.f, 0.f, 0.f};
            const bf16_t* qb = Qp + (size_t)(tok0 + l15) * 2048 + h * 256 + ph * 128 + lq * 8;
            const bf16_t* kb = keys + ((size_t)(h * 2 + ph) * 128 + l15) * 128 + lq * 8;
#pragma unroll 1
            for (int kk = 0; kk < 4; ++kk) {
                const bf16x8 bq = *(const bf16x8*)(qb + kk * 32);
#pragma unroll
                for (int i = 0; i < 8; ++i) { const bf16x8 ak = *(const bf16x8*)(kb + (size_t)i * 16 * 128 + kk * 32); acc[i] = __builtin_amdgcn_mfma_f32_16x16x32_bf16(ak, bq, acc[i], 0, 0, 0); }
            }
            int pv[32];
#pragma unroll
            for (int i = 0; i < 8; ++i)
#pragma unroll
                for (int j = 0; j < 4; ++j) pv[i * 4 + j] = (f2sort(acc[i][j]) & ~127) | (i * 16 + lq * 4 + j);
#pragma unroll
            for (int r = 0; r < 16; ++r) {
                int m = pv[0];
#pragma unroll
                for (int x = 1; x < 32; ++x) m = max(m, pv[x]);
                m = max(m, __shfl_xor(m, 16)); m = max(m, __shfl_xor(m, 32));
                if (lq == 0) scr[l15 * 32 + ph * 16 + r] = m;
#pragma unroll
                for (int x = 0; x < 32; ++x) pv[x] = (pv[x] == m) ? (int)0x80000000 : pv[x];
            }
        }
        __builtin_amdgcn_fence(__ATOMIC_RELEASE, "wavefront"); __builtin_amdgcn_wave_barrier(); __builtin_amdgcn_fence(__ATOMIC_ACQUIRE, "wavefront");
        int cv[13];
#pragma unroll
        for (int i = 0; i < 13; ++i) {
            const int c = lq * 13 + i;
            const float s = sort2f(scr[l15 * 32 + PAIR_A[c]] & ~127) + sort2f(scr[l15 * 32 + 16 + PAIR_B[c]] & ~127);
            cv[i] = (c < 50) ? ((f2sort(s) & ~63) | c) : (int)0x80000000;
        }
        int win[16];
#pragma unroll
        for (int r = 0; r < 16; ++r) {
            int m = cv[0];
#pragma unroll
            for (int x = 1; x < 13; ++x) m = max(m, cv[x]);
            m = max(m, __shfl_xor(m, 16)); m = max(m, __shfl_xor(m, 32));
            win[r] = m;
#pragma unroll
            for (int x = 0; x < 13; ++x) cv[x] = (cv[x] == m) ? (int)0x80000000 : cv[x];
        }
        const float v0 = sort2f(win[0] & ~63);
        float ev[16], den = 0.f;
#pragma unroll
        for (int r = 0; r < 16; ++r) { ev[r] = __expf(sort2f(win[r] & ~63) - v0); den += ev[r]; }
        const float rden = 1.f / den;
        if (lq == 0) {
            const size_t ob = (size_t)(tok0 + l15) * 128 + h * 16;
#pragma unroll
            for (int r = 0; r < 16; ++r) {
                const int c = win[r] & 63;
                const int e = (scr[l15 * 32 + PAIR_A[c]] & 127) * 128 + (scr[l15 * 32 + 16 + PAIR_B[c]] & 127);
                EX[ob + r] = e; GT[ob + r] = ev[r] * rden;
            }
        }
        __builtin_amdgcn_fence(__ATOMIC_RELEASE, "wavefront"); __builtin_amdgcn_wave_barrier(); __builtin_amdgcn_fence(__ATOMIC_ACQUIRE, "wavefront");
    }
}

DEVINL void phase_experts(const Params& p, int layer, int nrows, int final_mode) {
    const int lane = threadIdx.x & 63, gw = blockIdx.x * NWAVES + (threadIdx.x >> 6), ngw = gridDim.x * NWAVES;
    const bf16_t* F = (const bf16_t*)(p.ws + WS_R1);
    const bf16_t* UB = (const bf16_t*)(p.ws + WS_R3); const bf16_t* VBf = UB + (size_t)16384 * 1024;
    const int* EX = (const int*)(p.ws + WS_R2); const float* GT = (const float*)(p.ws + WS_R2 + (size_t)TALL * 128 * 4);
    float* XR = (float*)(p.ws + WS_XR);
    for (int row = gw; row < nrows; row += ngw) {
        float fa[8], fb[8], acc[16];
        { const u32x4 a = *(const u32x4*)(F + (size_t)row * DM + lane * 8), b = *(const u32x4*)(F + (size_t)row * DM + 512 + lane * 8); unpack8(a, fa); unpack8(b, fb); }
#pragma unroll
        for (int i = 0; i < 16; ++i) acc[i] = 0.f;
        const int id0 = EX[(size_t)row * 128 + lane], id1 = EX[(size_t)row * 128 + 64 + lane];
        const float g0 = GT[(size_t)row * 128 + lane], g1 = GT[(size_t)row * 128 + 64 + lane];
        for (int grp = 0; grp < 16; ++grp) {
            const int idv = grp < 8 ? id0 : id1; const float gv = grp < 8 ? g0 : g1; const int lb = (grp & 7) * 8;
            u32x4 ua[8], ub[8], va[8], vb[8]; float gt[8];
#pragma unroll
            for (int j = 0; j < 8; ++j) {
                const int e = __shfl(idv, lb + j); gt[j] = __shfl(gv, lb + j);
                const bf16_t* ur = UB + (size_t)e * 1024 + lane * 8; const bf16_t* vr = VBf + (size_t)e * 1024 + lane * 8;
                ua[j] = *(const u32x4*)ur; ub[j] = *(const u32x4*)(ur + 512); va[j] = *(const u32x4*)vr; vb[j] = *(const u32x4*)(vr + 512);
            }
#pragma unroll
            for (int j = 0; j < 8; ++j) {
                float t[8], d = 0.f;
                unpack8(ua[j], t);
#pragma unroll
                for (int i = 0; i < 8; ++i) d += t[i] * fa[i];
                unpack8(ub[j], t);
#pragma unroll
                for (int i = 0; i < 8; ++i) d += t[i] * fb[i];
                d = wave_sum(d);
                const float hcoef = gt[j] * gelu_f(d);
                unpack8(va[j], t);
#pragma unroll
                for (int i = 0; i < 8; ++i) acc[i] += hcoef * t[i];
                unpack8(vb[j], t);
#pragma unroll
                for (int i = 0; i < 8; ++i) acc[8 + i] += hcoef * t[i];
            }
        }
        const int bb = row_bb(row);
        const float* g2 = mod_ptr(p, layer, bb, 5);
        float x2[16]; float ss = 0.f;
#pragma unroll
        for (int hlf = 0; hlf < 2; ++hlf) {
            const int c0 = hlf * 512 + lane * 8;
            float* xp = XR + (size_t)row * DM + c0;
            const f32x4 xa = *(const f32x4*)xp, xb = *(const f32x4*)(xp + 4), ga = *(const f32x4*)(g2 + c0), gb = *(const f32x4*)(g2 + c0 + 4);
            float* o = x2 + hlf * 8; const float* a = acc + hlf * 8;
            o[0] = xa.x + ga.x * a[0]; o[1] = xa.y + ga.y * a[1]; o[2] = xa.z + ga.z * a[2]; o[3] = xa.w + ga.w * a[3];
            o[4] = xb.x + gb.x * a[4]; o[5] = xb.y + gb.y * a[5]; o[6] = xb.z + gb.z * a[6]; o[7] = xb.w + gb.w * a[7];
#pragma unroll
            for (int i = 0; i < 8; ++i) ss += o[i] * o[i];
            if (!final_mode) { *(f32x4*)xp = (f32x4){o[0], o[1], o[2], o[3]}; *(f32x4*)(xp + 4) = (f32x4){o[4], o[5], o[6], o[7]}; }
        }
        const float rinv = rsqrtf(wave_sum(ss) * (1.f / DM) + EPS);
        if (final_mode) {
#pragma unroll
            for (int hlf = 0; hlf < 2; ++hlf) {
                const int c0 = hlf * 512 + lane * 8; const float* o = x2 + hlf * 8;
                const f32x4 ga = *(const f32x4*)(p.in[22] + c0), gb = *(const f32x4*)(p.in[22] + c0 + 4);
                *(f32x4*)(p.out + (size_t)row * DM + c0) = (f32x4){o[0] * rinv * ga.x, o[1] * rinv * ga.y, o[2] * rinv * ga.z, o[3] * rinv * ga.w};
                *(f32x4*)(p.out + (size_t)row * DM + c0 + 4) = (f32x4){o[4] * rinv * gb.x, o[5] * rinv * gb.y, o[6] * rinv * gb.z, o[7] * rinv * gb.w};
            }
        } else {
            const float* gain = p.in[6] + 1024; const float* sh = mod_ptr(p, 1, bb, 0); const float* sc = mod_ptr(p, 1, bb, 1);
            bf16_t* H = (bf16_t*)(p.ws + WS_R1);
#pragma unroll
            for (int hlf = 0; hlf < 2; ++hlf) {
                const int c0 = hlf * 512 + lane * 8; const float* o = x2 + hlf * 8; float y[8];
#pragma unroll
                for (int i = 0; i < 8; ++i) y[i] = o[i] * rinv * gain[c0 + i] * (1.f + sc[c0 + i]) + sh[c0 + i];
                u32x4 w; w.x = pk2(y[0], y[1]); w.y = pk2(y[2], y[3]); w.z = pk2(y[4], y[5]); w.w = pk2(y[6], y[7]);
                *(u32x4*)(H + (size_t)row * DM + c0) = w;
            }
        }
    }
}

DEVINL void phase_gla_prep(const Params& p, char* smem) {
    float* sG = (float*)smem;
    float* sTot = sG + 64 * 32;
    const int tid = threadIdx.x, d = tid & 127, tq = tid >> 7;
    const float* G = (const float*)(p.ws + WS_G);
    const bf16_t* QK = (const bf16_t*)(p.ws + WS_R3);
    bf16_t* QREL[2] = {(bf16_t*)(p.ws + WS_R1), (bf16_t*)(p.ws + WS_R2)};
    bf16_t* KEND[2] = {(bf16_t*)(p.ws + WS_R1 + SZ_HALF_R), (bf16_t*)(p.ws + WS_R2 + SZ_HALF_R)};
    float* DEND = (float*)(p.ws + WS_DEND);
    const float* gw_ = p.in[14]; const float* gb_ = p.in[15];
    for (int u = blockIdx.x; u < 528 * 4; u += gridDim.x) {
        const int cidx = u >> 2, h = u & 3, row0 = cidx * 64;
        __syncthreads();
        *(f32x4*)(sG + tid * 4) = *(const f32x4*)(G + (size_t)row0 * 32 + tid * 4);
        __syncthreads();
        float lg[2][16];
#pragma unroll
        for (int dir = 0; dir < 2; ++dir) {
            float w[16];
#pragma unroll
            for (int j = 0; j < 16; ++j) w[j] = gw_[(dir * 16 + j) * 512 + h * 128 + d];
            const float bias = gb_[dir * 512 + h * 128 + d];
            float tot = 0.f;
#pragma unroll
            for (int i = 0; i < 16; ++i) {
                const float* gr = sG + (tq * 16 + i) * 32 + dir * 16;
                float x = bias;
#pragma unroll
                for (int j = 0; j < 16; ++j) x += gr[j] * w[j];
                lg[dir][i] = logsig_f(x) * (1.f / 16.f); tot += lg[dir][i];
            }
            sTot[(dir * 4 + tq) * 128 + d] = tot;
        }
        __syncthreads();
#pragma unroll
        for (int dir = 0; dir < 2; ++dir) {
            const float t0 = sTot[(dir * 4 + 0) * 128 + d], t1 = sTot[(dir * 4 + 1) * 128 + d], t2 = sTot[(dir * 4 + 2) * 128 + d], t3 = sTot[(dir * 4 + 3) * 128 + d];
            const float bend = (t0 + t1) + (t2 + t3);
            float run;
            if (dir == 0) run = (tq > 0 ? t0 : 0.f) + (tq > 1 ? t1 : 0.f) + (tq > 2 ? t2 : 0.f);
            else run = (tq < 3 ? t3 : 0.f) + (tq < 2 ? t2 : 0.f) + (tq < 1 ? t1 : 0.f);
#pragma unroll
            for (int ii = 0; ii < 16; ++ii) {
                const int i = dir == 0 ? ii : 15 - ii;
                run += lg[dir][i];
                const size_t row = (size_t)row0 + tq * 16 + i;
                const float qv = bf2f(QK[row * 1024 + h * 128 + d]), kv = bf2f(QK[row * 1024 + 512 + h * 128 + d]);
                QREL[dir][row * 512 + h * 128 + d] = (bf16_t)f2bf(qv * 0.08838834764831845f * __expf(run - bend));
                KEND[dir][row * 512 + h * 128 + d] = (bf16_t)f2bf(kv * __expf(bend - run));
            }
            if (tq == 0) DEND[((size_t)dir * 528 + cidx) * 512 + h * 128 + d] = __expf(bend);
        }
    }
}

constexpr int C_QS = 136, C_TS = 72;
DEVINL void phase_gla_chain(const Params& p, char* smem) {
    bf16_t* sQ = (bf16_t*)smem;
    bf16_t* sK = sQ + 64 * C_QS;
    bf16_t* sKT = sK + 64 * C_QS;
    bf16_t* sVT = sKT + 128 * C_TS;
    bf16_t* sSdT = sVT + 32 * C_TS;
    bf16_t* sP = sSdT + 32 * C_QS;
    float* sD = (float*)(sP + 64 * C_TS);
    const int tid = threadIdx.x, lane = tid & 63, w = tid >> 6, l15 = lane & 15, lq = lane >> 4;
    const bf16_t* VR = (const bf16_t*)(p.ws + WS_R4);
    const float* DEND = (const float*)(p.ws + WS_DEND);
    const int G = gridDim.x, vcu = (G % 8 == 0) ? (blockIdx.x % 8) * (G / 8) + blockIdx.x / 8 : blockIdx.x;
    for (int ch = vcu; ch < 256; ch += G) {
        const int vs = ch & 7, dir = (ch >> 3) & 1, h = (ch >> 4) & 3, b = ch >> 6;
        const bf16_t* QREL = (const bf16_t*)(p.ws + (dir ? WS_R2 : WS_R1));
        const bf16_t* KEND = (const bf16_t*)(p.ws + (dir ? WS_R2 : WS_R1) + SZ_HALF_R);
        bf16_t* OD = (bf16_t*)p.out + (dir ? (size_t)TLAT * 1024 : 0);
        f32x4 S[2]; S[0] = (f32x4){0.f, 0.f, 0.f, 0.f}; S[1] = S[0];
        for (int n = 0; n < 132; ++n) {
            int row0; bool lat;
            if (n < 4) { lat = false; row0 = TLAT + b * CTX + 64 * (dir ? 3 - n : n); }
            else { lat = true; row0 = b * SEQ + 64 * (dir ? 127 - (n - 4) : n - 4); }
            __syncthreads();
#pragma unroll
            for (int i = 0; i < 2; ++i) {
                const int chn = tid + i * NTHREADS, r = chn >> 4, c16 = chn & 15;
                const u32x4 qv = *(const u32x4*)(QREL + (size_t)(row0 + r) * 512 + h * 128 + c16 * 8);
                const u32x4 kv = *(const u32x4*)(KEND + (size_t)(row0 + r) * 512 + h * 128 + c16 * 8);
                *(u32x4*)(sQ + r * C_QS + c16 * 8) = qv; *(u32x4*)(sK + r * C_QS + c16 * 8) = kv;
                bf16_t* kt = sKT + (c16 * 8) * C_TS + r;
                kt[0] = (bf16_t)(kv.x & 0xffff); kt[C_TS] = (bf16_t)(kv.x >> 16); kt[2 * C_TS] = (bf16_t)(kv.y & 0xffff); kt[3 * C_TS] = (bf16_t)(kv.y >> 16);
                kt[4 * C_TS] = (bf16_t)(kv.z & 0xffff); kt[5 * C_TS] = (bf16_t)(kv.z >> 16); kt[6 * C_TS] = (bf16_t)(kv.w & 0xffff); kt[7 * C_TS] = (bf16_t)(kv.w >> 16);
            }
            if (tid < 256) {
                const int r = tid >> 2, c = tid & 3;
                const u32x4 vv = *(const u32x4*)(VR + (size_t)(row0 + r) * 2048 + h * 256 + vs * 32 + c * 8);
                bf16_t* vt = sVT + (c * 8) * C_TS + r;
                vt[0] = (bf16_t)(vv.x & 0xffff); vt[C_TS] = (bf16_t)(vv.x >> 16); vt[2 * C_TS] = (bf16_t)(vv.y & 0xffff); vt[3 * C_TS] = (bf16_t)(vv.y >> 16);
                vt[4 * C_TS] = (bf16_t)(vv.z & 0xffff); vt[5 * C_TS] = (bf16_t)(vv.z >> 16); vt[6 * C_TS] = (bf16_t)(vv.w & 0xffff); vt[7 * C_TS] = (bf16_t)(vv.w >> 16);
            }
            if (tid < 128) sD[tid] = DEND[((size_t)dir * 528 + (row0 >> 6)) * 512 + h * 128 + tid];
            __syncthreads();
            {
                const f32x4 dv = *(const f32x4*)(sD + 16 * w + lq * 4);
#pragma unroll
                for (int nt = 0; nt < 2; ++nt) {
                    S[nt] = S[nt] * dv;
                    u32x2 o; o.x = pk2(S[nt].x, S[nt].y); o.y = pk2(S[nt].z, S[nt].w);
                    *(u32x2*)(sSdT + (nt * 16 + l15) * C_QS + 16 * w + lq * 4) = o;
                }
            }
            {
                const int ct = w >> 1;
#pragma unroll
                for (int si = 0; si < 2; ++si) {
                    const int st = 2 * (w & 1) + si;
                    f32x4 a = (f32x4){0.f, 0.f, 0.f, 0.f};
#pragma unroll
                    for (int kk = 0; kk < 4; ++kk) {
                        const bf16x8 ka = *(const bf16x8*)(sK + (st * 16 + l15) * C_QS + kk * 32 + lq * 8);
                        const bf16x8 qb = *(const bf16x8*)(sQ + (ct * 16 + l15) * C_QS + kk * 32 + lq * 8);
                        a = __builtin_amdgcn_mfma_f32_16x16x32_bf16(ka, qb, a, 0, 0, 0);
                    }
                    const int c = ct * 16 + l15, s0 = st * 16 + lq * 4;
                    float pv[4];
#pragma unroll
                    for (int j = 0; j < 4; ++j) { const int s = s0 + j; const bool keep = dir ? (s >= c) : (s <= c); pv[j] = keep ? a[j] : 0.f; }
                    u32x2 o; o.x = pk2(pv[0], pv[1]); o.y = pk2(pv[2], pv[3]);
                    *(u32x2*)(sP + c * C_TS + s0) = o;
                }
            }
            __syncthreads();
            {
                const int ct = w >> 1, nt = w & 1;
                f32x4 a = (f32x4){0.f, 0.f, 0.f, 0.f};
#pragma unroll
                for (int ss = 0; ss < 2; ++ss) {
                    const bf16x8 va = *(const bf16x8*)(sVT + (nt * 16 + l15) * C_TS + ss * 32 + lq * 8);
                    const bf16x8 pb = *(const bf16x8*)(sP + (ct * 16 + l15) * C_TS + ss * 32 + lq * 8);
                    a = __builtin_amdgcn_mfma_f32_16x16x32_bf16(va, pb, a, 0, 0, 0);
                }
#pragma unroll
                for (int kk = 0; kk < 4; ++kk) {
                    const bf16x8 sa = *(const bf16x8*)(sSdT + (nt * 16 + l15) * C_QS + kk * 32 + lq * 8);
                    const bf16x8 qb = *(const bf16x8*)(sQ + (ct * 16 + l15) * C_QS + kk * 32 + lq * 8);
                    a = __builtin_amdgcn_mfma_f32_16x16x32_bf16(sa, qb, a, 0, 0, 0);
                }
                if (lat) {
                    u32x2 o; o.x = pk2(a.x, a.y); o.y = pk2(a.z, a.w);
                    *(u32x2*)(OD + (size_t)(row0 + ct * 16 + l15) * 1024 + h * 256 + vs * 32 + nt * 16 + lq * 4) = o;
                }
            }
#pragma unroll
            for (int nt = 0; nt < 2; ++nt)
#pragma unroll
                for (int ss = 0; ss < 2; ++ss) {
                    const bf16x8 ka = *(const bf16x8*)(sKT + (16 * w + l15) * C_TS + ss * 32 + lq * 8);
                    const bf16x8 vb = *(const bf16x8*)(sVT + (nt * 16 + l15) * C_TS + ss * 32 + lq * 8);
                    S[nt] = __builtin_amdgcn_mfma_f32_16x16x32_bf16(ka, vb, S[nt], 0, 0, 0);
                }
        }
    }
}

DEVINL void phase_gla_post(const Params& p) {
    const int lane = threadIdx.x & 63, gw = blockIdx.x * NWAVES + (threadIdx.x >> 6), ngw = gridDim.x * NWAVES;
    const bf16_t* OF = (const bf16_t*)p.out; const bf16_t* OB = OF + (size_t)TLAT * 1024;
    const bf16_t* VR = (const bf16_t*)(p.ws + WS_R4);
    bf16_t* Y = (bf16_t*)(p.ws + WS_R1);
    const f32x4 hg = *(const f32x4*)(p.in[16] + lane * 4);
    for (int row = gw; row < TLAT; row += ngw) {
#pragma unroll
        for (int h = 0; h < 4; ++h) {
            const int c = h * 256 + lane * 4;
            const u32x2 a = *(const u32x2*)(OF + (size_t)row * 1024 + c), b = *(const u32x2*)(OB + (size_t)row * 1024 + c), r = *(const u32x2*)(VR + (size_t)row * 2048 + 1024 + c);
            const float o0 = bf2f(a.x & 0xffff) + bf2f(b.x & 0xffff), o1 = bf2f(a.x >> 16) + bf2f(b.x >> 16), o2 = bf2f(a.y & 0xffff) + bf2f(b.y & 0xffff), o3 = bf2f(a.y >> 16) + bf2f(b.y >> 16);
            const float rinv = rsqrtf(wave_sum((o0 * o0 + o1 * o1) + (o2 * o2 + o3 * o3)) * (1.f / 256.f) + EPS);
            u32x2 y; y.x = pk2(o0 * rinv * hg.x * silu_f(bf2f(r.x & 0xffff)), o1 * rinv * hg.y * silu_f(bf2f(r.x >> 16)));
            y.y = pk2(o2 * rinv * hg.z * silu_f(bf2f(r.y & 0xffff)), o3 * rinv * hg.w * silu_f(bf2f(r.y >> 16)));
            *(u32x2*)(Y + (size_t)row * 1024 + c) = y;
        }
    }
}

DEVINL void run_phase(const Params& p, int ph, char* smem) {
    unsigned char* ws = p.ws;
#ifdef ONLY_PHASE
    ph = ONLY_PHASE;
#endif
    switch (ph) {
    case 0: phase_prologue(p, smem); break;
    case 1: phase_norm_mod(p, p.in[0], p.in[2], TALL, p.in[6], 0, 0, 1, (bf16_t*)(ws + WS_R1)); break;
    case 2: gemm_simple(( const bf16_t*)(ws + WS_R1), (const bf16_t*)(ws + WS_WT_ATTN_IN), TALL, ATTN_IN, DM, smem, EpiBf16{(bf16_t*)(ws + WS_R4), ATTN_IN}); break;
    case 3: phase_qkpost(p); break;
    case 4: phase_attn_naive(p, smem); break;
    case 5: gemm_simple((const bf16_t*)(ws + WS_R4), (const bf16_t*)(ws + WS_WT_ATTN_OUT), TALL, DM, DM, smem, EpiResid{p.in[0], p.in[2], (float*)(ws + WS_XR), mod_ptr(p, 0, 0, 2)}); break;
    case 6: phase_norm_mod(p, (const float*)(ws + WS_XR), (const float*)(ws + WS_XR) + (size_t)TLAT * DM, TALL, p.in[7], 0, 3, 4, (bf16_t*)(ws + WS_R1));
            convert_flat(p.in[20], (bf16_t*)(ws + WS_R3), (size_t)16384 * 1024); convert_flat(p.in[21], (bf16_t*)(ws + WS_R3) + (size_t)16384 * 1024, (size_t)16384 * 1024); break;
    case 7: gemm_simple((const bf16_t*)(ws + WS_R1), (const bf16_t*)(ws + WS_WT_PQ0), TALL, 2048, DM, smem, EpiBf16{(bf16_t*)(ws + WS_R4), 2048}); break;
    case 8: phase_topk(p, 0, TALL, smem); break;
    case 9: phase_experts(p, 0, TALL, 0); break;
    case 10: gemm_simple((const bf16_t*)(ws + WS_R1), (const bf16_t*)(ws + WS_WT_GLA_IN), TALL, 3200, DM, smem, EpiGla{(bf16_t*)(ws + WS_R3), (bf16_t*)(ws + WS_R4), (float*)(ws + WS_G)}); break;
    case 11: phase_gla_prep(p, smem); break;
    case 12: phase_gla_chain(p, smem); break;
    case 13: phase_gla_post(p); break;
    case 14: gemm_simple((const bf16_t*)(ws + WS_R1), (const bf16_t*)(ws + WS_WT_GLA_OUT), TLAT, DM, DM, smem, EpiResid{(const float*)(ws + WS_XR), (const float*)(ws + WS_XR) + (size_t)TLAT * DM, (float*)(ws + WS_XR), mod_ptr(p, 1, 0, 2)}); break;
    case 15: phase_norm_mod(p, (const float*)(ws + WS_XR), (const float*)(ws + WS_XR) + (size_t)TLAT * DM, TLAT, p.in[7] + 1024, 1, 3, 4, (bf16_t*)(ws + WS_R1));
             convert_flat(p.in[20] + (size_t)16384 * 1024, (bf16_t*)(ws + WS_R3), (size_t)16384 * 1024); convert_flat(p.in[21] + (size_t)16384 * 1024, (bf16_t*)(ws + WS_R3) + (size_t)16384 * 1024, (size_t)16384 * 1024); break;
    case 16: gemm_simple((const bf16_t*)(ws + WS_R1), (const bf16_t*)(ws + WS_WT_PQ1), TLAT, 2048, DM, smem, EpiBf16{(bf16_t*)(ws + WS_R4), 2048}); break;
    case 17: phase_topk(p, 1, TLAT, smem); break;
    case 18: phase_experts(p, 1, TLAT, 1); break;
    default: break;
    }
}

__global__ void __launch_bounds__(NTHREADS) fwd_kernel(Params p, int ph_lo, int ph_hi) {
    extern __shared__ __attribute__((aligned(16))) char smem[];
    cg::grid_group grid = cg::this_grid();
#define PHASE(k) if (ph_lo <= (k) && (k) < ph_hi) { run_phase(p, (k), smem); if ((k) + 1 < ph_hi) grid.sync(); }
    PHASE(0) PHASE(1) PHASE(2) PHASE(3) PHASE(4) PHASE(5) PHASE(6) PHASE(7) PHASE(8) PHASE(9)
    PHASE(10) PHASE(11) PHASE(12) PHASE(13) PHASE(14) PHASE(15) PHASE(16) PHASE(17) PHASE(18)
#undef PHASE
}

extern "C" void kernel_launch(void* const* d_in, const int* in_sizes, int n_in, void* d_out, int out_size, void* d_ws, size_t ws_size, hipStream_t stream) {
    static int grid = 0;
    if (grid == 0) {
        if (n_in != 23 || ws_size < WS_END || out_size != TLAT * DM) { fprintf(stderr, "kernel_launch: unexpected problem (n_in %d, ws %zu, out %d)\n", n_in, ws_size, out_size); grid = -1; return; }
        int dev = 0, cus = 0, per_cu = 0;
        hipGetDevice(&dev);
        hipDeviceGetAttribute(&cus, hipDeviceAttributeMultiprocessorCount, dev);
        hipFuncSetAttribute((const void*)fwd_kernel, hipFuncAttributeMaxDynamicSharedMemorySize, LDS_BYTES);
        hipOccupancyMaxActiveBlocksPerMultiprocessor(&per_cu, (const void*)fwd_kernel, NTHREADS, LDS_BYTES);
        if (per_cu < 1) { fprintf(stderr, "kernel_launch: occupancy query says %d blocks per CU\n", per_cu); grid = -1; return; }
        if (per_cu > 2) per_cu = 2;
        grid = cus * per_cu;
        fprintf(stderr, "kernel_launch: grid %d (%d per CU), ws %zu\n", grid, per_cu, ws_size);
    }
    if (grid < 0) return;
    Params p{};
    for (int i = 0; i < 23; ++i) p.in[i] = (const float*)d_in[i];
    p.out = (float*)d_out; p.ws = (unsigned char*)d_ws;
#if MULTI_LAUNCH
    for (int ph = 0; ph < NPHASES; ++ph) {
        hipLaunchKernelGGL(fwd_kernel, dim3(grid), dim3(NTHREADS), LDS_BYTES, stream, p, ph, ph + 1);
    }
#else
    int lo = 0, hi = NPHASES;
    void* args[] = {&p, &lo, &hi};
    hipError_t e = hipLaunchCooperativeKernel((const void*)fwd_kernel, dim3(grid), dim3(NTHREADS), args, LDS_BYTES, stream);
    if (e != hipSuccess) fprintf(stderr, "cooperative launch failed: %s (grid %d)\n", hipGetErrorString(e), grid);
#endif
}
```

```cpp
#include <hip/hip_runtime.h>
#include <hip/hip_cooperative_groups.h>
#include <cstdio>
#include <cstdint>
namespace cg = cooperative_groups;

#define DEVINL __device__ __forceinline__
typedef unsigned short bf16_t;
typedef short bf16x8 __attribute__((ext_vector_type(8)));
typedef float f32x4 __attribute__((ext_vector_type(4)));
typedef unsigned u32x4 __attribute__((ext_vector_type(4)));
typedef unsigned u32x2 __attribute__((ext_vector_type(2)));

constexpr int NB = 4, SEQ = 8192, DM = 1024, CTX = 256;
constexpr int TLAT = NB * SEQ;
constexpr int TCTX = NB * CTX;
constexpr int TALL = TLAT + TCTX;
constexpr int KVR = SEQ + CTX;
constexpr int NTHREADS = 512, NWAVES = 8;
constexpr float EPS = 1e-6f;
constexpr float LOG2E = 1.4426950408889634f;
constexpr float QSCALE = 0.125f * LOG2E;
constexpr int ATTN_IN = 1536, GLA_IN = 3104, GLA_IN_PAD = 3328;
constexpr int LDS_BYTES = 144 * 1024;

constexpr size_t MiB = 1u << 20;
constexpr size_t WS_MOD = 1 * MiB;
constexpr size_t WS_WT_ATTN_IN = 2 * MiB;
constexpr size_t WS_WT_ATTN_OUT = 5 * MiB;
constexpr size_t WS_WT_GLA_IN = 7 * MiB;
constexpr size_t WS_WT_GLA_OUT = 14 * MiB;
constexpr size_t WS_WT_PQ0 = 16 * MiB;
constexpr size_t WS_WT_PQ1 = 20 * MiB;
constexpr size_t WS_KEYS = 24 * MiB;
constexpr size_t WS_DEND = 25 * MiB;
constexpr size_t WS_G = 28 * MiB;
constexpr size_t WS_XR = 34 * MiB;
constexpr size_t WS_R1 = 166 * MiB;
constexpr size_t WS_R2 = 232 * MiB;
constexpr size_t WS_R3 = 298 * MiB;
constexpr size_t WS_R4 = 364 * MiB;
constexpr size_t WS_END = 496 * MiB;
constexpr size_t SZ_HALF_R = 33 * MiB;

struct Params {
    const float* in[23];
    float* out;
    unsigned char* ws;
};

DEVINL float bf2f(unsigned v) { return __uint_as_float(v << 16); }
DEVINL unsigned f2bf(float f) { unsigned u = __float_as_uint(f); return (u + 0x7fffu + ((u >> 16) & 1u)) >> 16; }
typedef float f32x2_pk __attribute__((ext_vector_type(2))); typedef __bf16 bf16x2_pk __attribute__((ext_vector_type(2)));
DEVINL unsigned pk2(float lo, float hi) { f32x2_pk v = {lo, hi}; bf16x2_pk b = __builtin_convertvector(v, bf16x2_pk); return __builtin_bit_cast(unsigned, b); }
DEVINL float wave_sum(float v) {
#pragma unroll
    for (int o = 1; o < 64; o <<= 1) v += __shfl_xor(v, o);
    return v;
}
DEVINL float silu_f(float x) { return x / (1.f + __expf(-x)); }
DEVINL float gelu_f(float x) { return 0.5f * x * (1.f + erff(x * 0.70710678118654752f)); }
DEVINL void unpack8(const u32x4 v, float* f) {
    f[0] = __uint_as_float(v.x << 16); f[1] = __uint_as_float(v.x & 0xffff0000u);
    f[2] = __uint_as_float(v.y << 16); f[3] = __uint_as_float(v.y & 0xffff0000u);
    f[4] = __uint_as_float(v.z << 16); f[5] = __uint_as_float(v.z & 0xffff0000u);
    f[6] = __uint_as_float(v.w << 16); f[7] = __uint_as_float(v.w & 0xffff0000u);
}
DEVINL int row_bb(int r) { return r < TLAT ? (r >> 13) : 4; }
DEVINL const float* mod_ptr(const Params& p, int l, int bb, int which) { return (const float*)(p.ws + WS_MOD) + ((size_t)((l * 5 + bb) * 6 + which)) * 1024; }

constexpr float W8_SCALE = 256.f;
template <bool F8W = false>
DEVINL void transpose_item(const float* W, int K, int N, int Npad, bf16_t* WT, int item, float* tile  ) {
    const int nt = Npad / 64, kb = item / nt, nb = item % nt, k0 = kb * 64, n0 = nb * 64, tid = threadIdx.x;
    {
        const int nn = tid & 63, kq = tid >> 6;
#pragma unroll
        for (int i = 0; i < 8; ++i) { const int kk = kq + 8 * i; const int n = n0 + nn; tile[kk * 65 + nn] = (n < N) ? W[(size_t)(k0 + kk) * N + n] : 0.f; }
    }
    __syncthreads();
    {
        const int c = tid & 7, nn = tid >> 3;
        const float* s = tile + (8 * c) * 65 + nn;
        if constexpr (F8W) {
#define T8C(i_) fminf(fmaxf(s[(i_) * 65] * W8_SCALE, -448.f), 448.f)
            int w0 = 0, w1 = 0;
            w0 = __builtin_amdgcn_cvt_pk_fp8_f32(T8C(0), T8C(1), w0, false); w0 = __builtin_amdgcn_cvt_pk_fp8_f32(T8C(2), T8C(3), w0, true);
            w1 = __builtin_amdgcn_cvt_pk_fp8_f32(T8C(4), T8C(5), w1, false); w1 = __builtin_amdgcn_cvt_pk_fp8_f32(T8C(6), T8C(7), w1, true);
#undef T8C
            u32x2 o; o.x = (unsigned)w0; o.y = (unsigned)w1;
            *(u32x2*)((unsigned char*)WT + (size_t)(n0 + nn) * K + k0 + 8 * c) = o;
        } else {
        u32x4 o; o.x = pk2(s[0], s[65]); o.y = pk2(s[2 * 65], s[3 * 65]); o.z = pk2(s[4 * 65], s[5 * 65]); o.w = pk2(s[6 * 65], s[7 * 65]);
        *(u32x4*)(WT + (size_t)(n0 + nn) * K + k0 + 8 * c) = o;
        }
    }
    __syncthreads();
}
DEVINL void phase_prologue(const Params& p, char* smem) {
    const int tid = threadIdx.x, lane = tid & 63, wid = tid >> 6;
    constexpr int I_MOD = 96;
    constexpr int I_T0 = 16 * 24, I_T1 = 16 * 16, I_T2 = 16 * 52, I_T3 = 16 * 16, I_T4 = 16 * 32, I_T5 = 16 * 32;
    constexpr int I_KEYS = 128;
    constexpr int NITEMS = I_MOD + I_T0 + I_T1 + I_T2 + I_T3 + I_T4 + I_T5 + I_KEYS;
    float* sS = (float*)(smem + 32768);
    if (blockIdx.x < I_MOD) {
        for (int i = tid; i < 5 * 1024; i += NTHREADS) sS[i] = silu_f(i < 4096 ? p.in[1][i] : p.in[3][i - 4096]);
        __syncthreads();
    }
    for (int it = blockIdx.x; it < NITEMS; it += gridDim.x) {
        int r = it;
        if (r < I_MOD) {
            const int wt = r * 8 + wid, l = wt / 384, n0 = (wt % 384) * 16, kq = lane >> 4, nn = lane & 15;
            const float* W = p.in[4] + (size_t)l * 1024 * 6144 + n0 + nn;
            float a0 = 0.f, a1 = 0.f, a2 = 0.f, a3 = 0.f, a4 = 0.f;
#pragma unroll 16
            for (int i = 0; i < 256; ++i) {
                const int k = kq + 4 * i;
                const float w = W[(size_t)k * 6144];
                a0 += sS[k] * w; a1 += sS[1024 + k] * w; a2 += sS[2048 + k] * w; a3 += sS[3072 + k] * w; a4 += sS[4096 + k] * w;
            }
            a0 += __shfl_xor(a0, 16); a0 += __shfl_xor(a0, 32); a1 += __shfl_xor(a1, 16); a1 += __shfl_xor(a1, 32); a2 += __shfl_xor(a2, 16); a2 += __shfl_xor(a2, 32);
            a3 += __shfl_xor(a3, 16); a3 += __shfl_xor(a3, 32); a4 += __shfl_xor(a4, 16); a4 += __shfl_xor(a4, 32);
            if (kq == 0) {
                const float bias = p.in[5][l * 6144 + n0 + nn];
                float* M = (float*)(p.ws + WS_MOD) + (size_t)l * 5 * 6144 + n0 + nn;
                M[0] = a0 + bias; M[6144] = a1 + bias; M[2 * 6144] = a2 + bias; M[3 * 6144] = a3 + bias; M[4 * 6144] = a4 + bias;
            }
            continue;
        }
        r -= I_MOD;
        float* tile = (float*)smem;
        if (r < I_T0) { transpose_item<true>(p.in[8], 1024, 1536, 1536, (bf16_t*)(p.ws + WS_WT_ATTN_IN), r, tile); continue; } r -= I_T0;
        if (r < I_T1) { transpose_item<true>(p.in[12], 1024, 1024, 1024, (bf16_t*)(p.ws + WS_WT_ATTN_OUT), r, tile); continue; } r -= I_T1;
        if (r < I_T2) { transpose_item<true>(p.in[13], 1024, GLA_IN, GLA_IN_PAD, (bf16_t*)(p.ws + WS_WT_GLA_IN), r, tile); continue; } r -= I_T2;
        if (r < I_T3) { transpose_item<true>(p.in[17], 1024, 1024, 1024, (bf16_t*)(p.ws + WS_WT_GLA_OUT), r, tile); continue; } r -= I_T3;
        if (r < I_T4) { transpose_item<true>(p.in[18], 1024, 2048, 2048, (bf16_t*)(p.ws + WS_WT_PQ0), r, tile); continue; } r -= I_T4;
        if (r < I_T5) { transpose_item<true>(p.in[18] + (size_t)1024 * 2048, 1024, 2048, 2048, (bf16_t*)(p.ws + WS_WT_PQ1), r, tile); continue; } r -= I_T5;
        {
            const size_t e0 = ((size_t)r * 512 + tid) * 8;
            const f32x4 a = *(const f32x4*)(p.in[19] + e0), b = *(const f32x4*)(p.in[19] + e0 + 4);
            u32x4 o; o.x = pk2(a.x, a.y); o.y = pk2(a.z, a.w); o.z = pk2(b.x, b.y); o.w = pk2(b.z, b.w);
            *(u32x4*)((bf16_t*)(p.ws + WS_KEYS) + e0) = o;
        }
    }
}

constexpr float F8_SCALE = 32.f, O8_SCALE = 32.f, Y8_SCALE = 16.f;
DEVINL void phase_norm_mod(const Params& p, const float* src_lat, const float* src_ctx, int nrows, const float* gain, int layer, int w_sh, int w_sc, bf16_t* dst, unsigned char* dst8 = nullptr) {
    const int lane = threadIdx.x & 63, gw = blockIdx.x * NWAVES + (threadIdx.x >> 6), ngw = gridDim.x * NWAVES;
#define NM_ROWPTR(r_) ((r_) < TLAT ? src_lat + (size_t)(r_) * DM : src_ctx + (size_t)((r_) - TLAT) * DM)
    f32x4 nv[4];
    if (gw < nrows) {
#pragma unroll
        for (int j = 0; j < 4; ++j) nv[j] = *(const f32x4*)(NM_ROWPTR(gw) + (j * 64 + lane) * 4);
    }
    for (int row = gw; row < nrows; row += ngw) {
        const int bb = row_bb(row);
        const float* sh = mod_ptr(p, layer, bb, w_sh); const float* sc = mod_ptr(p, layer, bb, w_sc);
        f32x4 v[4]; float ss = 0.f;
#pragma unroll
        for (int j = 0; j < 4; ++j) { v[j] = nv[j]; ss += (v[j].x * v[j].x + v[j].y * v[j].y) + (v[j].z * v[j].z + v[j].w * v[j].w); }
        if (row + ngw < nrows) {
#pragma unroll
            for (int j = 0; j < 4; ++j) nv[j] = *(const f32x4*)(NM_ROWPTR(row + ngw) + (j * 64 + lane) * 4);
        }
        const float rinv = rsqrtf(wave_sum(ss) * (1.f / DM) + EPS);
#pragma unroll
        for (int j = 0; j < 4; ++j) {
            const int c = (j * 64 + lane) * 4;
            const f32x4 g = *(const f32x4*)(gain + c), s1 = *(const f32x4*)(sc + c), s0 = *(const f32x4*)(sh + c);
            const float y0 = v[j].x * rinv * g.x * (1.f + s1.x) + s0.x, y1 = v[j].y * rinv * g.y * (1.f + s1.y) + s0.y, y2 = v[j].z * rinv * g.z * (1.f + s1.z) + s0.z, y3 = v[j].w * rinv * g.w * (1.f + s1.w) + s0.w;
            u32x2 o; o.x = pk2(y0, y1); o.y = pk2(y2, y3);
            if (dst) *(u32x2*)(dst + (size_t)row * DM + c) = o;
            if (dst8) {
                int w8 = 0; w8 = __builtin_amdgcn_cvt_pk_fp8_f32(fminf(fmaxf(y0 * F8_SCALE, -448.f), 448.f), fminf(fmaxf(y1 * F8_SCALE, -448.f), 448.f), w8, false);
                w8 = __builtin_amdgcn_cvt_pk_fp8_f32(fminf(fmaxf(y2 * F8_SCALE, -448.f), 448.f), fminf(fmaxf(y3 * F8_SCALE, -448.f), 448.f), w8, true);
                *(int*)(dst8 + (size_t)row * DM + c) = w8;
            }
        }
    }
}
#undef NM_ROWPTR

namespace pg8 {
#define PG8_LAS __attribute__((address_space(3)))
typedef unsigned short bf16_t;
typedef short bf16x8 __attribute__((ext_vector_type(8)));
typedef float f32x4 __attribute__((ext_vector_type(4)));
typedef unsigned u32x4 __attribute__((ext_vector_type(4)));
constexpr int BM = 256, BK = 64, HALF = 128, HTB = HALF * BK * 2  , STAGE_BYTES = 8 * HTB, NXCD = 8, WGM = 8;

__host__ __device__ __forceinline__ int lds_byte(int r, int c) { const int st = (r >> 4) * 2 + (c >> 5), rr = r & 15, cc = c & 31, ob = rr * 64 + cc * 2; return st * 1024 + (ob ^ (((ob >> 9) & 1) << 5)); }
__host__ __device__ __forceinline__ void stage_rc(int b, int& R, int& C) { const int st = b / 1024, sb = b % 1024, swz = sb ^ (((sb >> 9) & 1) << 5); R = (st >> 1) * 16 + swz / 64; C = (st & 1) * 32 + (swz % 64) / 2; }
__host__ __device__ __forceinline__ int perm32(int rho) { const int n = rho >> 4, i = rho & 15; return 8 * (i >> 2) + 4 * n + (i & 3); }

struct Unit { int pm, pn; };
struct Gemm { const bf16_t* A; const bf16_t* Bt; int M, N, K; };

struct StaticOrder {
    int nM, nN, nwg, G, c;
    __host__ __device__ void init(int M, int N, int G_, int c_) { nM = M / BM; nN = N / BM; nwg = nM * nN; G = G_; c = c_; }
    __host__ __device__ bool next(int i, Unit& u) const {
        const long L = (long)i * G + c; if (L >= nwg) return false;
        int wgid = (int)L; { const int q = nwg / NXCD, r = nwg % NXCD, xcd = wgid % NXCD, off = wgid / NXCD; wgid = (xcd < r ? xcd * (q + 1) : r * (q + 1) + (xcd - r) * q) + off; }
        const int nig = WGM * nN, gid = wgid / nig, fm = gid * WGM, gsz = (nM - fm) < WGM ? (nM - fm) : WGM;
        u.pm = fm + ((wgid % nig) % gsz); u.pn = (wgid % nig) / gsz; return true;
    }
    __device__ __forceinline__ void a_ready(const Unit&) const {}
    __device__ __forceinline__ void done(const Unit&) const {}
};

typedef int i32x4v __attribute__((ext_vector_type(4)));
typedef int i32x8v __attribute__((ext_vector_type(8)));
__device__ __forceinline__ i32x8v cat8(bf16x8 a, bf16x8 b) { return __builtin_shufflevector((i32x4v)a, (i32x4v)b, 0, 1, 2, 3, 4, 5, 6, 7); }
__device__ __forceinline__ unsigned cvt_pk_bf16(float lo, float hi) { unsigned r; asm volatile("v_cvt_pk_bf16_f32 %0, %1, %2" : "=v"(r) : "v"(lo), "v"(hi)); return r; }

struct EpiStoreBf16 {
    static constexpr bool PERM = true, AFTER_DRAIN = false;
    bf16_t* O; int ldc; float sc;
    __device__ __forceinline__ void operator()(const f32x4 (&acc)[2][2][4][2], const Unit& u, int wr, int wc, int fr, int fq) const {
        const int row0 = u.pm * BM + wr * 64 + fr, col0 = u.pn * BM + wc * 32 + 8 * fq;
#pragma unroll
        for (int ai = 0; ai < 2; ++ai)
#pragma unroll
            for (int m = 0; m < 4; ++m) { bf16_t* rowp = O + (size_t)(row0 + ai * HALF + m * 16) * ldc + col0;
#pragma unroll
                for (int bj = 0; bj < 2; ++bj) { const f32x4 v0 = acc[ai][bj][m][0] * sc, v1 = acc[ai][bj][m][1] * sc;
                    u32x4 w; w.x = cvt_pk_bf16(v0[0], v0[1]); w.y = cvt_pk_bf16(v0[2], v0[3]); w.z = cvt_pk_bf16(v1[0], v1[1]); w.w = cvt_pk_bf16(v1[2], v1[3]);
                    *(u32x4*)(rowp + bj * HALF) = w; } }
    }
};
struct EpiResidF32 {
    static constexpr bool PERM = true, AFTER_DRAIN = false;
    const float* xin_lat; const float* xin_ctx; float* XR; const float* gate_base; float sc;
    __device__ __forceinline__ void operator()(const f32x4 (&acc)[2][2][4][2], const Unit& u, int wr, int wc, int fr, int fq) const {
        const int row0 = u.pm * BM + wr * 64 + fr, col0 = u.pn * BM + wc * 32 + 8 * fq;
#pragma unroll
        for (int ai = 0; ai < 2; ++ai)
#pragma unroll
            for (int m = 0; m < 4; ++m) { const int row = row0 + ai * HALF + m * 16;
                const float* xi = row < TLAT ? xin_lat + (size_t)row * 1024 : xin_ctx + (size_t)(row - TLAT) * 1024;
                const float* gb = gate_base + (size_t)row_bb(row) * 6144; float* xo = XR + (size_t)row * 1024;
#pragma unroll
                for (int bj = 0; bj < 2; ++bj)
#pragma unroll
                    for (int n = 0; n < 2; ++n) { const int c = col0 + bj * HALF + n * 4;
                        *(f32x4*)(xo + c) = *(const f32x4*)(xi + c) + *(const f32x4*)(gb + c) * (acc[ai][bj][m][n] * sc); } }
    }
};
struct EpiGla {
    static constexpr bool PERM = true, AFTER_DRAIN = false;
    bf16_t* QK; bf16_t* VR; float* G; float sc;
    __device__ __forceinline__ void operator()(const f32x4 (&acc)[2][2][4][2], const Unit& u, int wr, int wc, int fr, int fq) const {
        const int row0 = u.pm * BM + wr * 64 + fr, colt = u.pn * BM;
        if (colt < 3072) {
            bf16_t* base = colt < 1024 ? QK : VR; const int ldc = colt < 1024 ? 1024 : 2048, col0 = (colt < 1024 ? colt : colt - 1024) + wc * 32 + 8 * fq;
#pragma unroll
            for (int ai = 0; ai < 2; ++ai)
#pragma unroll
                for (int m = 0; m < 4; ++m) { bf16_t* rowp = base + (size_t)(row0 + ai * HALF + m * 16) * ldc + col0;
#pragma unroll
                    for (int bj = 0; bj < 2; ++bj) { const f32x4 v0 = acc[ai][bj][m][0] * sc, v1 = acc[ai][bj][m][1] * sc;
                        u32x4 w; w.x = cvt_pk_bf16(v0[0], v0[1]); w.y = cvt_pk_bf16(v0[2], v0[3]); w.z = cvt_pk_bf16(v1[0], v1[1]); w.w = cvt_pk_bf16(v1[2], v1[3]);
                        *(u32x4*)(rowp + bj * HALF) = w; } }
        } else if (wc == 0) {
#pragma unroll
            for (int ai = 0; ai < 2; ++ai)
#pragma unroll
                for (int m = 0; m < 4; ++m) { float* gp = G + (size_t)(row0 + ai * HALF + m * 16) * 32 + 8 * fq;
                    *(f32x4*)gp = acc[ai][0][m][0] * sc; *(f32x4*)(gp + 4) = acc[ai][0][m][1] * sc; }
        }
    }
};

template <class Epi, class Sched, bool ALIGN_EPI = false, bool SP2 = false, bool F8 = false>
__device__ __forceinline__ void gemm_phase(PG8_LAS unsigned char* lds, const Gemm g, const Sched& S, const Epi& E) {
    const int tid = threadIdx.x, wid = __builtin_amdgcn_readfirstlane(tid >> 6), lane = tid & 63, wr = wid >> 2, wc = wid & 3, fr = lane & 15, fq = lane >> 4;
    const int K = g.K, nt = K / BK;
    unsigned voffA[2], voffB[2];
#pragma unroll
    for (int i = 0; i < 2; ++i) { int R, C; stage_rc(tid * 16 + i * 8192, R, C); const int Rb = Epi::PERM ? ((R & ~31) + perm32(R & 31)) : R;
        voffA[i] = (unsigned)(R * K + C) * 2u; voffB[i] = (unsigned)(Rb * K + C) * 2u; }
    const size_t kstep = (size_t)(BK * 2);
    const size_t hstep = (size_t)HALF * K * 2;
    const size_t tstep = 2 * hstep;
    const unsigned ldsw = (unsigned)wid * 1024u;
    const int aoff = lds_byte(wr * 64 + fr, fq * 8), boff = lds_byte(wc * 32 + fr, fq * 8);
#define PG8_SA(b, h) (((b) * 2 + (h)) * HTB)
#define PG8_SB(b, h) ((4 + (b) * 2 + (h)) * HTB)
#define PG8_STAGE(bufoff, gbase, voff) do { _Pragma("unroll") for (int _i = 0; _i < 2; ++_i) \
        __builtin_amdgcn_global_load_lds((const unsigned*)((const char*)(gbase) + (voff)[_i]), (PG8_LAS unsigned*)(lds + (bufoff) + ldsw + _i * 8192), 16, 0, 0); } while (0)
#define PG8_LDA(dst, b, h) do { _Pragma("unroll") for (int m = 0; m < 4; ++m) { if constexpr (F8) dst##8[m] = cat8(*(const PG8_LAS bf16x8*)(lds + PG8_SA(b, h) + aoff + m * 2048), *(const PG8_LAS bf16x8*)(lds + PG8_SA(b, h) + aoff + m * 2048 + 1024)); \
        else { _Pragma("unroll") for (int k = 0; k < 2; ++k) dst[m][k] = *(const PG8_LAS bf16x8*)(lds + PG8_SA(b, h) + aoff + m * 2048 + k * 1024); } } } while (0)
#define PG8_LDB(dst, b, h) do { _Pragma("unroll") for (int n = 0; n < 2; ++n) { if constexpr (F8) dst##8[n] = cat8(*(const PG8_LAS bf16x8*)(lds + PG8_SB(b, h) + boff + n * 2048), *(const PG8_LAS bf16x8*)(lds + PG8_SB(b, h) + boff + n * 2048 + 1024)); \
        else { _Pragma("unroll") for (int k = 0; k < 2; ++k) dst[n][k] = *(const PG8_LAS bf16x8*)(lds + PG8_SB(b, h) + boff + n * 2048 + k * 1024); } } } while (0)
#define PG8_MMA(ai, bj, At, Bt) do { __builtin_amdgcn_s_setprio(1); _Pragma("unroll") for (int m = 0; m < 4; ++m) _Pragma("unroll") for (int n = 0; n < 2; ++n) { \
        if constexpr (F8) asm volatile("v_mfma_f32_16x16x128_f8f6f4 %0, %1, %2, %0" : "+v"(acc[ai][bj][m][n]) : "v"(Bt##8[n]), "v"(At##8[m]));   \
        else { _Pragma("unroll") for (int k = 0; k < 2; ++k) acc[ai][bj][m][n] = __builtin_amdgcn_mfma_f32_16x16x32_bf16(Bt[n][k], At[m][k], acc[ai][bj][m][n], 0, 0, 0); } } __builtin_amdgcn_s_setprio(0); } while (0)
#define PG8_WAIT_V(n) asm volatile("s_waitcnt vmcnt(" #n ")" ::: "memory")
#define PG8_WAIT_L(n) asm volatile("s_waitcnt lgkmcnt(" #n ")" ::: "memory")
#define PG8_BAR __builtin_amdgcn_s_barrier()
#define PG8_SCHED __builtin_amdgcn_sched_barrier(0)
    Unit cur, nxt; int ui = 0;
    if (!S.next(0, cur)) return;
    f32x4 acc[2][2][4][2];
#pragma unroll
    for (int a = 0; a < 2; ++a)
#pragma unroll
        for (int b = 0; b < 2; ++b)
#pragma unroll
            for (int m = 0; m < 4; ++m)
#pragma unroll
                for (int n = 0; n < 2; ++n) acc[a][b][m][n] = (f32x4){0.f, 0.f, 0.f, 0.f};
    bf16x8 At[4][2], B0[2][2], B1[2][2];
    i32x8v At8[4], B08[2], B18[2];
    const char* cA = (const char*)g.A + (size_t)cur.pm * tstep; const char* cB = (const char*)g.Bt + (size_t)cur.pn * tstep;
    S.a_ready(cur);
    if constexpr (SP2) {
        PG8_STAGE(PG8_SB(0, 0), cB, voffB); PG8_STAGE(PG8_SB(0, 1), cB + hstep, voffB); PG8_STAGE(PG8_SA(0, 0), cA, voffA); PG8_STAGE(PG8_SA(0, 1), cA + hstep, voffA);
        if (wr == 1) PG8_BAR;
        PG8_WAIT_V(2); PG8_BAR;
        PG8_STAGE(PG8_SB(1, 0), cB + kstep, voffB); PG8_STAGE(PG8_SA(1, 0), cA + kstep, voffA); PG8_STAGE(PG8_SB(1, 1), cB + hstep + kstep, voffB);
        PG8_WAIT_V(6); PG8_BAR;
    } else {
        PG8_STAGE(PG8_SB(0, 0), cB, voffB); PG8_STAGE(PG8_SA(0, 0), cA, voffA); PG8_STAGE(PG8_SB(0, 1), cB + hstep, voffB); PG8_STAGE(PG8_SA(0, 1), cA + hstep, voffA);
        if (wr == 1) PG8_BAR;
        PG8_WAIT_V(4); PG8_BAR;
        PG8_STAGE(PG8_SB(1, 0), cB + kstep, voffB); PG8_STAGE(PG8_SA(1, 0), cA + kstep, voffA); PG8_STAGE(PG8_SB(1, 1), cB + hstep + kstep, voffB);
        PG8_WAIT_V(6); PG8_BAR;
    }
    for (;;) {
        const bool has_next = S.next(ui + 1, nxt);
        const char* nA = has_next ? (const char*)g.A + (size_t)nxt.pm * tstep : cA; const char* nB = has_next ? (const char*)g.Bt + (size_t)nxt.pn * tstep : cB;
#pragma unroll 1
        for (int t = 0; t < nt; t += 2) {
            const bool last = (t == nt - 2);
            const char* a1 = cA + (size_t)(t + 1) * kstep;
            const char* a2 = last ? nA : cA + (size_t)(t + 2) * kstep; const char* b2 = last ? nB : cB + (size_t)(t + 2) * kstep;
            const char* a3 = a2 + kstep; const char* b3 = b2 + kstep;
            if (last && has_next) S.a_ready(nxt);
            if constexpr (SP2) {
            PG8_LDB(B0, 0, 0); PG8_LDB(B1, 0, 1); PG8_SCHED; PG8_LDA(At, 0, 0); PG8_STAGE(PG8_SA(1, 1), a1 + hstep, voffA);
            PG8_WAIT_V(8); PG8_WAIT_L(0); PG8_BAR; PG8_MMA(0, 0, At, B0); PG8_MMA(0, 1, At, B1); PG8_BAR; PG8_SCHED;
            PG8_LDA(At, 0, 1); PG8_STAGE(PG8_SB(0, 0), b2, voffB); PG8_STAGE(PG8_SB(0, 1), b2 + hstep, voffB); PG8_STAGE(PG8_SA(0, 0), a2, voffA);
            PG8_WAIT_V(8); PG8_WAIT_L(0); PG8_BAR; PG8_MMA(1, 0, At, B0); PG8_MMA(1, 1, At, B1); PG8_BAR; PG8_SCHED;
            PG8_LDB(B0, 1, 0); PG8_LDB(B1, 1, 1); PG8_SCHED; PG8_LDA(At, 1, 0); PG8_STAGE(PG8_SA(0, 1), a2 + hstep, voffA);
            PG8_WAIT_V(8); PG8_WAIT_L(0); PG8_BAR; PG8_MMA(0, 0, At, B0); PG8_MMA(0, 1, At, B1); PG8_BAR; PG8_SCHED;
            PG8_LDA(At, 1, 1); PG8_STAGE(PG8_SB(1, 0), b3, voffB); PG8_STAGE(PG8_SB(1, 1), b3 + hstep, voffB); PG8_STAGE(PG8_SA(1, 0), a3, voffA);
            PG8_WAIT_V(8); PG8_WAIT_L(0); PG8_BAR; PG8_MMA(1, 0, At, B0); PG8_MMA(1, 1, At, B1); PG8_BAR; PG8_SCHED;
            } else {
            PG8_LDB(B0, 0, 0); PG8_SCHED; PG8_LDA(At, 0, 0); PG8_STAGE(PG8_SA(1, 1), a1 + hstep, voffA);
            PG8_WAIT_L(8); PG8_BAR; PG8_WAIT_L(0); PG8_MMA(0, 0, At, B0); PG8_BAR; PG8_SCHED;
            PG8_LDB(B1, 0, 1); PG8_STAGE(PG8_SB(0, 0), b2, voffB);
            PG8_BAR; PG8_WAIT_L(0); PG8_MMA(0, 1, At, B1); PG8_BAR;
            PG8_LDA(At, 0, 1); PG8_STAGE(PG8_SA(0, 0), a2, voffA);
            PG8_BAR; PG8_WAIT_L(0); PG8_MMA(1, 0, At, B0); PG8_BAR; PG8_SCHED;
            PG8_STAGE(PG8_SB(0, 1), b2 + hstep, voffB);
            PG8_WAIT_V(6); PG8_BAR; PG8_MMA(1, 1, At, B1); PG8_BAR;
            PG8_LDB(B0, 1, 0); PG8_SCHED; PG8_LDA(At, 1, 0); PG8_STAGE(PG8_SA(0, 1), a2 + hstep, voffA);
            PG8_WAIT_L(8); PG8_BAR; PG8_WAIT_L(0); PG8_MMA(0, 0, At, B0); PG8_BAR; PG8_SCHED;
            PG8_LDB(B1, 1, 1); PG8_STAGE(PG8_SB(1, 0), b3, voffB);
            PG8_BAR; PG8_WAIT_L(0); PG8_MMA(0, 1, At, B1); PG8_BAR;
            PG8_LDA(At, 1, 1); PG8_STAGE(PG8_SA(1, 0), a3, voffA);
            PG8_BAR; PG8_WAIT_L(0); PG8_MMA(1, 0, At, B0); PG8_BAR; PG8_SCHED;
            PG8_STAGE(PG8_SB(1, 1), b3 + hstep, voffB);
            PG8_WAIT_V(6); PG8_BAR; PG8_MMA(1, 1, At, B1); PG8_BAR;
            }
        }
        if constexpr (F8) asm volatile("s_nop 15\n\ts_nop 15" ::: "memory");
        if constexpr (ALIGN_EPI) { if (wr == 0) PG8_BAR; }
        if constexpr (!Epi::AFTER_DRAIN) { E(acc, cur, wr, wc, fr, fq); S.done(cur); }
        if (!has_next) break;
#pragma unroll
        for (int a = 0; a < 2; ++a)
#pragma unroll
            for (int b = 0; b < 2; ++b)
#pragma unroll
                for (int m = 0; m < 4; ++m)
#pragma unroll
                    for (int n = 0; n < 2; ++n) acc[a][b][m][n] = (f32x4){0.f, 0.f, 0.f, 0.f};
        cur = nxt; cA = nA; cB = nB; ++ui;
        if constexpr (ALIGN_EPI) { if (wr == 1) PG8_BAR; }
    }
    PG8_WAIT_V(0);
    if constexpr (!ALIGN_EPI) { if (wr == 0) PG8_BAR; }
    PG8_BAR;
    if constexpr (Epi::AFTER_DRAIN) { E.fused(acc, cur, wr, wc, fr, fq, lds, wid, lane); S.done(cur); }
#undef PG8_SA
#undef PG8_SB
#undef PG8_STAGE
#undef PG8_LDA
#undef PG8_LDB
#undef PG8_MMA
#undef PG8_WAIT_V
#undef PG8_WAIT_L
#undef PG8_BAR
#undef PG8_SCHED
}
}

DEVINL void phase_qkpost(const Params& p) {
    const int lane = threadIdx.x & 63, gw = blockIdx.x * NWAVES + (threadIdx.x >> 6), ngw = gridDim.x * NWAVES;
    const bf16_t* P0 = (const bf16_t*)(p.ws + WS_R4);
    bf16_t* Q = (bf16_t*)(p.ws + WS_R2);
    bf16_t* KA = (bf16_t*)(p.ws + WS_R3); bf16_t* VA = KA + (size_t)NB * KVR * 128; bf16_t* KB = VA + (size_t)NB * KVR * 128; bf16_t* VB = KB + (size_t)NB * KVR * 128;
    const int hs = lane >> 3, c8 = lane & 7, d0 = c8 * 8;
    const int ax = c8 >> 2, hf = (c8 >> 1) & 1, p0 = (c8 & 1) * 8;
    float qg[8], kg[8], inv[8];
#pragma unroll
    for (int i = 0; i < 8; ++i) { qg[i] = p.in[10][d0 + i]; kg[i] = p.in[11][d0 + i]; inv[i] = exp2f(-(float)(p0 + i) * (13.287712379549449f / 16.f)) * 0.15915494309189535f; }
    for (int row = gw; row < TALL; row += ngw) {
        const bool lat = row < TLAT;
        float cs[8], sn[8]; size_t kvrow;
        if (lat) {
            const int b = row >> 13, t = row & 8191; const float pos = (float)(ax ? (t & 63) : (t >> 6)); kvrow = (size_t)b * KVR + CTX + t;
#pragma unroll
            for (int i = 0; i < 8; ++i) { const float rev = pos * inv[i]; const float fr = rev - floorf(rev); sn[i] = __builtin_amdgcn_sinf(fr); cs[i] = __builtin_amdgcn_cosf(fr); }
        } else {
            const int rc = row - TLAT, b = rc >> 8, j = rc & 255; kvrow = (size_t)b * KVR + j;
#pragma unroll
            for (int i = 0; i < 8; ++i) { sn[i] = 0.f; cs[i] = 1.f; }
        }
        u32x4 raw[3];
#pragma unroll
        for (int g = 0; g < 3; ++g) raw[g] = *(const u32x4*)(P0 + (size_t)row * ATTN_IN + g * 512 + lane * 8);
#pragma unroll
        for (int g = 0; g < 3; ++g) {
            const int slot = g * 8 + hs;
            float v[8]; unpack8(raw[g], v);
            const bool isq = (slot < 8) || (slot >= 12 && slot < 20);
            const bool isv = (slot == 10 || slot == 11 || slot >= 22);
            const bool isB = slot >= 12;
            float ss = 0.f;
#pragma unroll
            for (int i = 0; i < 8; ++i) ss += v[i] * v[i];
            ss += __shfl_xor(ss, 1); ss += __shfl_xor(ss, 2); ss += __shfl_xor(ss, 4);
            const float rn = rsqrtf(ss * (1.f / 64.f) + EPS);
            float o[8];
#pragma unroll
            for (int i = 0; i < 8; ++i) {
                float x = v[i];
                if (isB && !isv) x = x * rn * (isq ? qg[i] : kg[i]);
                const float pt = __shfl_xor(x, 2);
                if (!isv) x = hf ? (pt * sn[i] + x * cs[i]) : (x * cs[i] - pt * sn[i]);
                if (isq) x *= QSCALE;
                o[i] = x;
            }
            u32x4 w; w.x = pk2(o[0], o[1]); w.y = pk2(o[2], o[3]); w.z = pk2(o[4], o[5]); w.w = pk2(o[6], o[7]);
            bf16_t* dst;
            if (slot < 8) dst = Q + (size_t)row * 1024 + slot * 64;
            else if (slot < 10) dst = KA + kvrow * 128 + (slot - 8) * 64;
            else if (slot < 12) dst = VA + kvrow * 128 + (slot - 10) * 64;
            else if (slot < 20) dst = Q + (size_t)row * 1024 + 512 + (slot - 12) * 64;
            else if (slot < 22) dst = KB + kvrow * 128 + (slot - 20) * 64;
            else dst = VB + kvrow * 128 + (slot - 22) * 64;
            *(u32x4*)(dst + d0) = w;
        }
    }
}

namespace attn_body {
using bf16=unsigned short;
using bf16x8=__attribute__((ext_vector_type(8)))short;
using s16x4=__attribute__((ext_vector_type(4)))short;
using f32x16=__attribute__((ext_vector_type(16)))float;
using u32x4=__attribute__((ext_vector_type(4)))unsigned;
constexpr int D=64,QP=1024,KP=128;
constexpr int NW=8,QBLK=32,QB=QBLK*NW,KVBLK=64;
__device__ __forceinline__ int crow(int r,int hi){return (r&3)+8*(r>>2)+4*hi;}
__device__ __forceinline__ unsigned f2bf_attn(float f){unsigned u=__float_as_uint(f);return (u+0x7fffu+((u>>16)&1u))>>16;}
#define SBAR() __builtin_amdgcn_sched_barrier(0)
__device__ __forceinline__ void cmask(f32x16&p0,f32x16&p1,int kbase,int qpos,int hi){
  const float NEG=-INFINITY; const int kb=kbase+4*hi-qpos;
  #pragma unroll
  for(int r=0;r<16;++r){int dd=kb+(r&3)+8*(r>>2); if(dd>128||dd<-128)p0[r]=NEG; dd+=32; if(dd>128||dd<-128)p1[r]=NEG;}
}

constexpr int NSLOT=3, SLOTB=8192;
constexpr int LDS_K=0, LDS_V=NSLOT*SLOTB, LDS_WS=2*NSLOT*SLOTB, LDS_OST=LDS_WS+NW*64*4, LDS_BYTES=LDS_OST+NW*4096;
constexpr float C2=0.125f*1.4426950408889634f;
__device__ __forceinline__ void glds16(const void*gsrc,unsigned lds_dst){unsigned keep;
  asm volatile("s_mov_b32 %0, m0\n\ts_mov_b32 m0, %2\n\ts_nop 0\n\tglobal_load_lds_dwordx4 %1, off\n\ts_mov_b32 m0, %0":"=&s"(keep):"v"(gsrc),"s"(lds_dst):"memory");}
__device__ __forceinline__ float max3f(float a,float b,float c){float r;asm("v_max3_f32 %0, %1, %2, %3":"=v"(r):"v"(a),"v"(b),"v"(c));return r;}
__device__ __forceinline__ float max2f(float a,float b){float r;asm("v_max_f32_e32 %0, %1, %2":"=v"(r):"v"(a),"v"(b));return r;}
__device__ __forceinline__ float fadd_s(float a,float b){float r;asm("v_add_f32_e32 %0, %1, %2":"=v"(r):"v"(a),"v"(b));return r;}
__device__ __forceinline__ float fsub_s(float a,float b){float r;asm("v_sub_f32_e32 %0, %1, %2":"=v"(r):"v"(a),"v"(b));return r;}
typedef float f32x2_t __attribute__((ext_vector_type(2))); typedef __bf16 bf16x2_t __attribute__((ext_vector_type(2)));
__device__ __forceinline__ unsigned cvtpk_s(float lo,float hi){f32x2_t v={lo,hi};bf16x2_t b=__builtin_convertvector(v,bf16x2_t);return __builtin_bit_cast(unsigned,b);}
#define WAIT_BAR(N) asm volatile("s_waitcnt vmcnt(" #N ") lgkmcnt(0)\n\ts_barrier":::"memory")

__device__ __forceinline__ void qkt(f32x16&p0,f32x16&p1,const char*Kslot,const bf16x8*qr,const f32x16&negm,int r32,int hi){
  const char*kb=Kslot+hi*1024+r32*16;
  #pragma unroll
  for(int d0=0;d0<4;++d0){
    const bf16x8 b0=*reinterpret_cast<const bf16x8*>(kb+d0*2048);
    const bf16x8 b1=*reinterpret_cast<const bf16x8*>(kb+d0*2048+512);
    if(d0==0){p0=__builtin_amdgcn_mfma_f32_32x32x16_bf16(b0,qr[0],negm,0,0,0);p1=__builtin_amdgcn_mfma_f32_32x32x16_bf16(b1,qr[0],negm,0,0,0);}
    else{p0=__builtin_amdgcn_mfma_f32_32x32x16_bf16(b0,qr[d0],p0,0,0,0);p1=__builtin_amdgcn_mfma_f32_32x32x16_bf16(b1,qr[d0],p1,0,0,0);}}
}
typedef __attribute__((address_space(3))) const char* lds_cptr;
typedef short v4i16_t __attribute__((ext_vector_type(4)));
__device__ __forceinline__ void kload8(bf16x8*kf,lds_cptr kp){
  kf[0]=*(const __attribute__((address_space(3))) bf16x8*)(kp);      kf[1]=*(const __attribute__((address_space(3))) bf16x8*)(kp+512);
  kf[2]=*(const __attribute__((address_space(3))) bf16x8*)(kp+2048); kf[3]=*(const __attribute__((address_space(3))) bf16x8*)(kp+2560);
  kf[4]=*(const __attribute__((address_space(3))) bf16x8*)(kp+4096); kf[5]=*(const __attribute__((address_space(3))) bf16x8*)(kp+4608);
  kf[6]=*(const __attribute__((address_space(3))) bf16x8*)(kp+6144); kf[7]=*(const __attribute__((address_space(3))) bf16x8*)(kp+6656);
}
__device__ __forceinline__ void kload2(bf16x8*kf,lds_cptr kp,int j){ kf[2*j]=*(const __attribute__((address_space(3))) bf16x8*)(kp+j*2048); kf[2*j+1]=*(const __attribute__((address_space(3))) bf16x8*)(kp+j*2048+512); }
__device__ __forceinline__ s16x4 vtr(lds_cptr p){ return __builtin_bit_cast(s16x4,__builtin_amdgcn_ds_read_tr16_b64_v4i16((__attribute__((address_space(3))) v4i16_t*)p)); }
__device__ __forceinline__ float rowmax(const f32x16&p0,const f32x16&p1){
  float a=max3f(p0[0],p0[1],p1[0]),b=max3f(p0[2],p0[3],p1[1]);a=max3f(a,p1[2],p1[3]);
  #pragma unroll
  for(int r=4;r<16;r+=4){a=max3f(a,p0[r],p0[r+1]);b=max3f(b,p0[r+2],p0[r+3]);a=max3f(a,p1[r],p1[r+1]);b=max3f(b,p1[r+2],p1[r+3]);}
  const float m=max2f(a,b);
  auto rr=__builtin_amdgcn_permlane32_swap(__float_as_uint(m),__float_as_uint(m),false,false);
  return max2f(__uint_as_float(rr[0]),__uint_as_float(rr[1]));
}
__device__ __forceinline__ void pv(f32x16*o,int vb,bf16x8 pa0,bf16x8 pa1,bf16x8 pa2,bf16x8 pa3){
  #pragma unroll
  for(int d0=0;d0<2;++d0){s16x4 lo[4],hi[4];
    #pragma unroll
    for(int ks=0;ks<4;++ks){
      asm volatile("ds_read_b64_tr_b16 %0,%1 offset:%c2":"=&v"(lo[ks]):"v"(vb),"i"(d0*4096+ks*1024):"memory");
      asm volatile("ds_read_b64_tr_b16 %0,%1 offset:%c2":"=&v"(hi[ks]):"v"(vb),"i"(d0*4096+ks*1024+512):"memory");}
    asm volatile("s_waitcnt lgkmcnt(0)":::"memory");SBAR();
    #define PK(k) (bf16x8){lo[k][0],lo[k][1],lo[k][2],lo[k][3],hi[k][0],hi[k][1],hi[k][2],hi[k][3]}
    o[d0]=__builtin_amdgcn_mfma_f32_32x32x16_bf16(pa0,PK(0),o[d0],0,0,0);
    o[d0]=__builtin_amdgcn_mfma_f32_32x32x16_bf16(pa1,PK(1),o[d0],0,0,0);
    o[d0]=__builtin_amdgcn_mfma_f32_32x32x16_bf16(pa2,PK(2),o[d0],0,0,0);
    o[d0]=__builtin_amdgcn_mfma_f32_32x32x16_bf16(pa3,PK(3),o[d0],0,0,0);
    #undef PK
  }
}

#ifndef ATTN_STORE16
#define ATTN_STORE16(p,v) (*(u32x4*)(p)=(v))
#endif
template<int THRL, bool NOMAX> __device__ __forceinline__ void attn_unit(const bf16*Qu,const bf16*__restrict__ Kh,const bf16*__restrict__ Vh,unsigned char*Ou,int NT,int extra,bool amode,int qpos0,float sink_l2,char*shm){
  const int tid=threadIdx.x,lane=tid&63,r32=lane&31,hi=lane>>5; const int wid=__builtin_amdgcn_readfirstlane(tid>>6);
  const bf16*Qw=Qu+(long)(wid*QBLK)*QP;
  const unsigned lds0=(unsigned)(uintptr_t)shm;
  float*wsf=(float*)(shm+LDS_WS)+wid*64;
  const bf16*ksrc=Kh+(long)lane*KP+wid*8;
  const bf16*vsrc=Vh+(long)(16*(wid&3)+(lane>>2))*KP+(wid>>2)*32+(lane&3)*8;
  const unsigned kdst=lds0+LDS_K+wid*1024, vdst=lds0+LDS_V+wid*1024;
  #define KOFF(t) ((long)(64*(t)+(((t)>=4)?extra:0))*KP)
  #define DMA_K(t,slot) glds16(ksrc+KOFF(t),(unsigned)__builtin_amdgcn_readfirstlane(kdst+(slot)))
  #define DMA_V(t,slot) glds16(vsrc+KOFF(t),(unsigned)__builtin_amdgcn_readfirstlane(vdst+(slot)))
  const int vb0=(int)(lds0+LDS_V)+((lane>>4)&1)*32+(lane&3)*8+(4*hi+((lane&15)>>2))*64;
  const char*Kbase=shm+LDS_K; bf16x8 kf[8];
  const lds_cptr shm3=(lds_cptr)shm; const lds_cptr kp0=shm3+LDS_K+hi*1024+r32*16; const lds_cptr vp0=shm3+LDS_V+((lane>>4)&1)*32+(lane&3)*8+(4*hi+((lane&15)>>2))*64;
  DMA_K(0,0);DMA_V(0,0);DMA_K(1,SLOTB);
  bf16x8 qr[4];
  #pragma unroll
  for(int d0=0;d0<4;++d0)qr[d0]=*reinterpret_cast<const bf16x8*>(&Qw[(long)r32*QP+d0*16+hi*8]);
  float mhat=0.f,l_reg=0.f;f32x16 o[2];o[0]=f32x16{};o[1]=f32x16{};f32x16 negm=f32x16{};asm volatile("":"+v"(negm));
  const int qpos=qpos0+wid*QBLK+r32;
  #define CMASK(P0,P1,t) do{ if(amode&&(t)>=4)cmask(P0,P1,extra-256+64*(t),qpos,hi);}while(0)
  bool resc=false;
  #define START(P0,P1) do{ resc=false; \
    if(!NOMAX){ const float rm=rowmax(P0,P1); const float dl=rm; mhat=fadd_s(mhat,dl); \
      _Pragma("unroll") for(int r=0;r<16;++r){P0[r]=fsub_s(P0[r],dl);P1[r]=fsub_s(P1[r],dl);} \
      _Pragma("unroll") for(int r=0;r<16;++r)negm[r]=-mhat; asm volatile("":"+v"(negm)); } \
    _Pragma("unroll") for(int r=0;r<16;++r)P0[r]=__builtin_amdgcn_exp2f(P0[r]); }while(0)
  #define RESC() do{ if(resc){ asm volatile("s_waitcnt lgkmcnt(0)":::"memory"); \
      _Pragma("unroll") for(int d_=0;d_<2;++d_) _Pragma("unroll") for(int r=0;r<16;++r)o[d_][r]*=wsf[crow(r,hi)]; } }while(0)
  f32x16 pA0,pA1,pB0,pB1;
  int sl_prev=0,sl_cur=0,sl_next=SLOTB;
  #define ROT() do{sl_prev=sl_cur;sl_cur=sl_next;sl_next=(sl_next==(NSLOT-1)*SLOTB)?0:sl_next+SLOTB;}while(0)
  DMA_K(2,2*SLOTB);
  WAIT_BAR(3);
  qkt(pA0,pA1,Kbase,qr,negm,r32,hi);asm volatile("s_nop 15\n\ts_nop 7":"+v"(pA0),"+v"(pA1));CMASK(pA0,pA1,0);
  START(pA0,pA1);
  _Pragma("unroll") for(int r=0;r<16;++r)pA1[r]=__builtin_amdgcn_exp2f(pA1[r]);
  WAIT_BAR(0);
  DMA_K(3,0);DMA_V(1,SLOTB);
  ROT();
  kload8(kf,kp0+sl_cur);
  WAIT_BAR(2);
  s16x4 vlo[8],vhi[8]; u32x4 pw0,pw1,pw2,pw3;
  #define PKW(P,B) cvtpk_s(P[B],P[B+1])
  #define PAF(k) __builtin_bit_cast(bf16x8,pw##k)
  #define VFR(i) (bf16x8){vlo[i][0],vlo[i][1],vlo[i][2],vlo[i][3],vhi[i][0],vhi[i][1],vhi[i][2],vhi[i][3]}
  #define PIN(x) asm volatile("":"+v"(x))
  #define MX3(a,b,c) __builtin_fmaxf(__builtin_fmaxf((a),(b)),(c))
  #define GAPA(MF,A0,A1,A2,A3,W0,W1,PW) do{ MF; sacc+=A0; sacc+=A1; sacc+=A2; sacc+=A3; PIN(sacc); W0; W1; PIN(PW); SBAR(); }while(0)
  #define EX(v) __builtin_amdgcn_exp2f(v)
  #define GAPB(MF,X,B) do{ MF; X[B]=EX(X[B]); X[B+1]=EX(X[B+1]); X[B+2]=EX(X[B+2]); X[B+3]=EX(X[B+3]); PIN(X); SBAR(); }while(0)
  #define VRD(i) do{ vlo[i]=vtr(vp_+(((i)>>2)*4096+((i)&3)*1024)); vhi[i]=vtr(vp_+(((i)>>2)*4096+((i)&3)*1024+512)); }while(0)
  #define KRD(G,j) do{ if(G){ kload2(kf,kp0+sl_next,j); SBAR(); } }while(0)
  #define STEP(C0,C1,P0,P1,t,GK,GV,GL) do{ SBAR(); \
    const lds_cptr vp_=vp0+sl_prev; \
    VRD(0); SBAR(); float sacc=(P0[0]+P0[1]); \
    GAPA(C0=__builtin_amdgcn_mfma_f32_32x32x16_bf16(kf[0],qr[0],negm,0,0,0), P0[2],P0[3],P0[4],P0[5],     pw0[0]=PKW(P0,0), pw0[1]=PKW(P0,2), pw0); \
    VRD(4); SBAR(); GAPA(C1=__builtin_amdgcn_mfma_f32_32x32x16_bf16(kf[1],qr[0],negm,0,0,0), P0[6],P0[7],P0[8],P0[9],     pw0[2]=PKW(P0,4), pw0[3]=PKW(P0,6), pw0); \
    VRD(1); SBAR(); GAPA(C0=__builtin_amdgcn_mfma_f32_32x32x16_bf16(kf[2],qr[1],C0,0,0,0),   P0[10],P0[11],P0[12],P0[13], pw1[0]=PKW(P0,8), pw1[1]=PKW(P0,10), pw1); \
    VRD(5); SBAR(); GAPA(C1=__builtin_amdgcn_mfma_f32_32x32x16_bf16(kf[3],qr[1],C1,0,0,0),   P0[14],P0[15],P1[0],P1[1],   pw1[2]=PKW(P0,12),pw1[3]=PKW(P0,14), pw1); \
    VRD(2); SBAR(); GAPA(C0=__builtin_amdgcn_mfma_f32_32x32x16_bf16(kf[4],qr[2],C0,0,0,0),   P1[2],P1[3],P1[4],P1[5],     pw2[0]=PKW(P1,0), pw2[1]=PKW(P1,2), pw2); \
    VRD(6); SBAR(); GAPA(C1=__builtin_amdgcn_mfma_f32_32x32x16_bf16(kf[5],qr[2],C1,0,0,0),   P1[6],P1[7],P1[8],P1[9],     pw2[2]=PKW(P1,4), pw2[3]=PKW(P1,6), pw2); \
    VRD(3); SBAR(); GAPA(C0=__builtin_amdgcn_mfma_f32_32x32x16_bf16(kf[6],qr[3],C0,0,0,0),   P1[10],P1[11],P1[12],P1[13], pw3[0]=PKW(P1,8), pw3[1]=PKW(P1,10), pw3); \
    VRD(7); SBAR(); GAPA(C1=__builtin_amdgcn_mfma_f32_32x32x16_bf16(kf[7],qr[3],C1,0,0,0),   P1[14],P1[15],0.f,0.f,       pw3[2]=PKW(P1,12),pw3[3]=PKW(P1,14), pw3); \
    l_reg+=sacc; \
    if(GK){DMA_K((t)+3,sl_cur);} if(GV){DMA_V((t)+1,sl_next);} \
    CMASK(C0,C1,t); \
    if(!NOMAX){ float a=MX3(C0[0],C0[1],C1[0]),b=MX3(C0[2],C0[3],C1[1]); a=MX3(a,C1[2],C1[3]); \
      _Pragma("unroll") for(int r=4;r<16;r+=4){a=MX3(a,C0[r],C0[r+1]);b=MX3(b,C0[r+2],C0[r+3]);a=MX3(a,C1[r],C1[r+1]);b=MX3(b,C1[r+2],C1[r+3]);} \
      float rm=__builtin_fmaxf(a,b); { auto rr=__builtin_amdgcn_permlane32_swap(__float_as_uint(rm),__float_as_uint(rm),false,false); rm=__builtin_fmaxf(__uint_as_float(rr[0]),__uint_as_float(rr[1])); } \
      resc=false; \
      if(__builtin_expect(__any(rm>(float)THRL),0)){ const float dl=__builtin_fmaxf(rm,0.f); mhat+=dl; \
        _Pragma("unroll") for(int r=0;r<16;++r){C0[r]-=dl;C1[r]-=dl;} \
        _Pragma("unroll") for(int r=0;r<16;++r)negm[r]=-mhat; asm volatile("":"+v"(negm)); \
        const float f=__builtin_amdgcn_exp2f(-dl); l_reg*=f; if(hi==0)wsf[r32]=f; resc=true; } } \
    SBAR(); \
    GAPB(o[0]=__builtin_amdgcn_mfma_f32_32x32x16_bf16(PAF(0),VFR(0),o[0],0,0,0), C0,0); \
    GAPB(o[1]=__builtin_amdgcn_mfma_f32_32x32x16_bf16(PAF(0),VFR(4),o[1],0,0,0), C0,4); \
    KRD(GL,0); GAPB(o[0]=__builtin_amdgcn_mfma_f32_32x32x16_bf16(PAF(1),VFR(1),o[0],0,0,0), C0,8); \
    KRD(GL,1); GAPB(o[1]=__builtin_amdgcn_mfma_f32_32x32x16_bf16(PAF(1),VFR(5),o[1],0,0,0), C0,12); \
    KRD(GL,2); GAPB(o[0]=__builtin_amdgcn_mfma_f32_32x32x16_bf16(PAF(2),VFR(2),o[0],0,0,0), C1,0); \
    KRD(GL,3); GAPB(o[1]=__builtin_amdgcn_mfma_f32_32x32x16_bf16(PAF(2),VFR(6),o[1],0,0,0), C1,4); \
    GAPB(o[0]=__builtin_amdgcn_mfma_f32_32x32x16_bf16(PAF(3),VFR(3),o[0],0,0,0), C1,8); \
    GAPB(o[1]=__builtin_amdgcn_mfma_f32_32x32x16_bf16(PAF(3),VFR(7),o[1],0,0,0), C1,12); \
    }while(0)
  int t=1;
  for(;t+5<NT;t+=2){
    STEP(pB0,pB1,pA0,pA1,t,true,true,true);     WAIT_BAR(2); RESC(); ROT();
    STEP(pA0,pA1,pB0,pB1,t+1,true,true,true);   WAIT_BAR(2); RESC(); ROT();
  }
  #define ENDW(tt) do{ if((tt)+3<NT){WAIT_BAR(2);} else if((tt)+2<NT){WAIT_BAR(1);} else {WAIT_BAR(0);} }while(0)
  for(;t+1<NT;t+=2){
    STEP(pB0,pB1,pA0,pA1,t,(t+3<NT),(t+1<NT),(t+1<NT));       ENDW(t);   RESC(); ROT();
    STEP(pA0,pA1,pB0,pB1,t+1,(t+4<NT),(t+2<NT),(t+2<NT));     ENDW(t+1); RESC(); ROT();
  }
  STEP(pB0,pB1,pA0,pA1,NT-1,false,false,false); RESC();
  { float sacc=pB0[0]+pB0[1]; _Pragma("unroll") for(int r=2;r<16;++r)sacc+=pB0[r]; _Pragma("unroll") for(int r=0;r<16;++r)sacc+=pB1[r]; l_reg+=sacc;
    pw0=(u32x4){PKW(pB0,0),PKW(pB0,2),PKW(pB0,4),PKW(pB0,6)};pw1=(u32x4){PKW(pB0,8),PKW(pB0,10),PKW(pB0,12),PKW(pB0,14)};pw2=(u32x4){PKW(pB1,0),PKW(pB1,2),PKW(pB1,4),PKW(pB1,6)};pw3=(u32x4){PKW(pB1,8),PKW(pB1,10),PKW(pB1,12),PKW(pB1,14)};
    SBAR(); pv(o,vb0+sl_cur,PAF(0),PAF(1),PAF(2),PAF(3)); }
  #undef PKW
  #undef PAF
  #undef VFR
  #undef PIN
  #undef MX3
  #undef GAPA
  #undef GAPB
  #undef EX
  #undef VRD
  #undef KRD
  #undef STEP
  #undef ENDW
  {auto rr=__builtin_amdgcn_permlane32_swap(__float_as_uint(l_reg),__float_as_uint(l_reg),false,false);l_reg=__uint_as_float(rr[0])+__uint_as_float(rr[1]);}
  l_reg+=__builtin_amdgcn_exp2f(sink_l2-mhat);
  if(hi==0)wsf[32+r32]=l_reg;asm volatile("s_waitcnt lgkmcnt(0)":::"memory");
  float rli[16];
  #pragma unroll
  for(int r=0;r<16;++r)rli[r]=__builtin_amdgcn_rcpf(wsf[32+crow(r,hi)]);
  unsigned char*Ow=Ou+(long)(wid*QBLK)*QP;
  { bf16*stg=(bf16*)(shm+LDS_OST)+wid*2048;
    #pragma unroll
    for(int r=0;r<16;++r){const int orow=crow(r,hi);
      #pragma unroll
      for(int d0=0;d0<2;++d0)stg[orow*64+d0*32+r32]=(bf16)f2bf_attn(o[d0][r]*rli[r]);}
    asm volatile("s_waitcnt lgkmcnt(0)":::"memory");
    #pragma unroll
    for(int i=0;i<4;++i){const int row=i*8+(lane>>3),ch=lane&7; const u32x4 v=*(const u32x4*)(stg+row*64+ch*8);
      #define O8C(w_,hi_) fminf(fmaxf(__uint_as_float((hi_)?((w_)&0xffff0000u):((w_)<<16))*O8_SCALE,-448.f),448.f)
      int w0=0,w1=0;
      w0=__builtin_amdgcn_cvt_pk_fp8_f32(O8C(v.x,0),O8C(v.x,1),w0,false);w0=__builtin_amdgcn_cvt_pk_fp8_f32(O8C(v.y,0),O8C(v.y,1),w0,true);
      w1=__builtin_amdgcn_cvt_pk_fp8_f32(O8C(v.z,0),O8C(v.z,1),w1,false);w1=__builtin_amdgcn_cvt_pk_fp8_f32(O8C(v.w,0),O8C(v.w,1),w1,true);
      #undef O8C
      u32x2 w;w.x=(unsigned)w0;w.y=(unsigned)w1;*(u32x2*)(Ow+(long)row*QP+ch*8)=w;} }
  asm volatile("s_waitcnt lgkmcnt(0)\n\ts_barrier":::"memory");
  #undef DMA_K
  #undef KOFF
  #undef DMA_V
  #undef CMASK
  #undef START
  #undef RESC
  #undef ROT
}
constexpr int ATTN_LDS_BYTES=LDS_BYTES;
#undef SBAR
#undef WAIT_BAR
}

DEVINL void phase_attn(const Params& p, char* smem) {
    const bf16_t* Q = (const bf16_t*)(p.ws + WS_R2);
    const bf16_t* KA = (const bf16_t*)(p.ws + WS_R3); const bf16_t* VA = KA + (size_t)NB * KVR * 128; const bf16_t* KB = VA + (size_t)NB * KVR * 128; const bf16_t* VB = KB + (size_t)NB * KVR * 128;
    unsigned char* O = p.ws + WS_R4;
    const int G = gridDim.x, vcu = (G % 8 == 0) ? (blockIdx.x % 8) * (G / 8) + blockIdx.x / 8 : blockIdx.x;
    float gq = 0.f, gk = 0.f;
    for (int i = 0; i < 64; ++i) { gq = fmaxf(gq, fabsf(p.in[10][i])); gk = fmaxf(gk, fabsf(p.in[11][i])); }
    const bool bounded = (8.f * gq * gk * LOG2E) < 40.f;
    for (int v = vcu; v < 256; v += G) {
        const int p8 = v >> 5, c32 = v & 31, b = p8 >> 1, kvh = p8 & 1;
        for (int i = 0; i < 9; ++i) {
            int typeB, g, NT, extra, qpos0; bool amode; size_t qrow0;
            if (i < 4) { typeB = 1; g = i; NT = 132; extra = 0; amode = false; qpos0 = c32 * 256; qrow0 = (size_t)b * SEQ + qpos0; }
            else if (i < 8) {
                typeB = 0; g = i - 4; qpos0 = c32 * 256; qrow0 = (size_t)b * SEQ + qpos0; amode = true;
                const int lo = qpos0 - 128 < 0 ? 0 : qpos0 - 128, hi = qpos0 + 384 > SEQ ? SEQ : qpos0 + 384;
                NT = 4 + (hi - lo) / 64; extra = lo;
            } else { if (c32 >= 8) break; typeB = c32 >> 2; g = c32 & 3; NT = 4; extra = 0; amode = false; qpos0 = 0; qrow0 = (size_t)TLAT + b * CTX; }
            const int hq = kvh * 4 + g, hcol = (typeB ? 512 : 0) + hq * 64;
            const float sink = typeB ? -INFINITY : p.in[9][hq] * LOG2E;
            const bf16_t* Kh = (typeB ? KB : KA) + (size_t)b * KVR * 128 + kvh * 64;
            const bf16_t* Vh = (typeB ? VB : VA) + (size_t)b * KVR * 128 + kvh * 64;
            if (typeB && bounded) attn_body::attn_unit<8, true>(Q + qrow0 * 1024 + hcol, Kh, Vh, O + qrow0 * 1024 + hcol, NT, extra, amode, qpos0, sink, smem);
            else attn_body::attn_unit<8, false>(Q + qrow0 * 1024 + hcol, Kh, Vh, O + qrow0 * 1024 + hcol, NT, extra, amode, qpos0, sink, smem);
        }
    }
}

__device__ const unsigned char PAIR_A[52] = {0,0,0,0,0,0,0,0,0,0,0,0,0,0,0,0, 1,1,1,1,1,1,1,1, 2,2,2,2,2, 3,3,3,3, 4,4,4, 5,5, 6,6, 7,7, 8,9,10,11,12,13,14,15, 0,0};
__device__ const unsigned char PAIR_B[52] = {0,1,2,3,4,5,6,7,8,9,10,11,12,13,14,15, 0,1,2,3,4,5,6,7, 0,1,2,3,4, 0,1,2,3, 0,1,2, 0,1, 0,1, 0,1, 0,0,0,0,0,0,0,0, 0,0};
DEVINL int f2sort(float f) { int s = __float_as_int(f); return s ^ ((s >> 31) & 0x7fffffff); }
DEVINL float sort2f(int s) { return __int_as_float(s ^ ((s >> 31) & 0x7fffffff)); }
DEVINL void bsort16_desc(int (&v)[16]) {
#pragma unroll
    for (int k = 2; k <= 16; k <<= 1)
#pragma unroll
        for (int j = k >> 1; j > 0; j >>= 1)
#pragma unroll
            for (int i = 0; i < 16; ++i) { const int l = i ^ j; if (l > i) { const bool desc = (i & k) == 0; const int hi = max(v[i], v[l]), lo = min(v[i], v[l]); v[i] = desc ? hi : lo; v[l] = desc ? lo : hi; } }
}
DEVINL void bmerge16_desc(int (&v)[16]) {
#pragma unroll
    for (int j = 8; j > 0; j >>= 1)
#pragma unroll
        for (int i = 0; i < 16; ++i) { const int l = i ^ j; if (l > i) { const int hi = max(v[i], v[l]), lo = min(v[i], v[l]); v[i] = hi; v[l] = lo; } }
}
DEVINL void top16_of_4x32(const int (&pv)[32], int (&t)[16]) {
    int a[16], b[16];
#pragma unroll
    for (int i = 0; i < 16; ++i) { a[i] = pv[i]; b[i] = pv[16 + i]; }
    bsort16_desc(a); bsort16_desc(b);
#pragma unroll
    for (int i = 0; i < 16; ++i) t[i] = max(a[i], b[15 - i]);
    bmerge16_desc(t);
#pragma unroll
    for (int lvl = 16; lvl <= 32; lvl <<= 1) {
        int o[16];
#pragma unroll
        for (int i = 0; i < 16; ++i) o[i] = __shfl_xor(t[15 - i], lvl);
#pragma unroll
        for (int i = 0; i < 16; ++i) t[i] = max(t[i], o[i]);
        bmerge16_desc(t);
    }
}
constexpr int TOPK_PTAB_OFF = 17408;
DEVINL void topk_pairs_init(char* smem) {
    int* ptab = (int*)(smem + TOPK_PTAB_OFF);
    if (threadIdx.x < 52) ptab[threadIdx.x] = (int)PAIR_A[threadIdx.x] | ((int)PAIR_B[threadIdx.x] << 4);
    __syncthreads();
}
struct TopkQ { bf16x8 q0[4], q1[4]; };
DEVINL void topk_load_q(const bf16_t* Qp, int tok0, int h, int lane, TopkQ& Q) {
    const bf16_t* qb = Qp + (size_t)(tok0 + (lane & 15)) * 2048 + h * 256 + (lane >> 4) * 8;
#pragma unroll
    for (int kk = 0; kk < 4; ++kk) { Q.q0[kk] = *(const bf16x8*)(qb + kk * 32); Q.q1[kk] = *(const bf16x8*)(qb + 128 + kk * 32); }
}
template <int KSTR, class OUT, bool QREG>
DEVINL void topk_task(TopkQ& Q, const bf16_t* qb  , const bf16_t* keys_h  , int h, int* scr, int lane, const int* ptab, const OUT& out,
                      const bf16_t* Qp_next = nullptr, int tok0 = 0) {
    const int l15 = lane & 15, lq = lane >> 4;
    f32x4 acc0[8], acc1[8];
#pragma unroll
    for (int i = 0; i < 8; ++i) { acc0[i] = (f32x4){0.f, 0.f, 0.f, 0.f}; acc1[i] = acc0[i]; }
    const bf16_t* kb = keys_h + (size_t)l15 * KSTR + lq * 8;
#define TOPK_KSTEP(kk_, bq0_, bq1_) do { bf16x8 ak0[8], ak1[8]; \
        _Pragma("unroll") for (int i = 0; i < 8; ++i) { ak0[i] = *(const bf16x8*)(kb + (size_t)i * 16 * KSTR + (kk_) * 32); ak1[i] = *(const bf16x8*)(kb + (size_t)(128 + i * 16) * KSTR + (kk_) * 32); } \
        __builtin_amdgcn_sched_barrier(0);     \
        _Pragma("unroll") for (int i = 0; i < 8; ++i) { acc0[i] = __builtin_amdgcn_mfma_f32_16x16x32_bf16(ak0[i], bq0_, acc0[i], 0, 0, 0); acc1[i] = __builtin_amdgcn_mfma_f32_16x16x32_bf16(ak1[i], bq1_, acc1[i], 0, 0, 0); } __builtin_amdgcn_sched_barrier(0); } while (0)
    if constexpr (QREG) {
#pragma unroll
        for (int kk = 0; kk < 4; ++kk) { TOPK_KSTEP(kk, Q.q0[kk], Q.q1[kk]); asm volatile("" ::: "memory"); }
    } else {
#pragma unroll 1
        for (int kk = 0; kk < 4; ++kk) { const bf16x8 bq0 = *(const bf16x8*)(qb + kk * 32), bq1 = *(const bf16x8*)(qb + 128 + kk * 32); TOPK_KSTEP(kk, bq0, bq1); }
    }
#undef TOPK_KSTEP
    if constexpr (QREG) { if (Qp_next) topk_load_q(Qp_next, tok0, h + 1, lane, Q); }
    int pv0[32], pv1[32];
#pragma unroll
    for (int i = 0; i < 8; ++i)
#pragma unroll
        for (int j = 0; j < 4; ++j) { pv0[i * 4 + j] = (f2sort(acc0[i][j]) & ~127) | (i * 16 + lq * 4 + j); pv1[i * 4 + j] = (f2sort(acc1[i][j]) & ~127) | (i * 16 + lq * 4 + j); }
    {
        int t0[16], t1[16];
        top16_of_4x32(pv0, t0); top16_of_4x32(pv1, t1);
        if (lq == 0) {
#pragma unroll
            for (int r = 0; r < 16; ++r) { scr[l15 * 33 + r] = t0[r]; scr[l15 * 33 + 16 + r] = t1[r]; }
        }
    }
    __builtin_amdgcn_fence(__ATOMIC_RELEASE, "wavefront"); __builtin_amdgcn_wave_barrier(); __builtin_amdgcn_fence(__ATOMIC_ACQUIRE, "wavefront");
    int win[16];
#pragma unroll
    for (int i = 0; i < 16; ++i) {
        if (i < 13) {
            const int ab = ptab[lq * 13 + i], a = ab & 15, b = ab >> 4;
            const float sv = sort2f(scr[l15 * 33 + a] & ~127) + sort2f(scr[l15 * 33 + 16 + b] & ~127);
            win[i] = (f2sort(sv) & ~255) | ab;
            if (i >= 11) { const int im = -(int)(lq * 13 + i >= 50); win[i] = (win[i] & ~im) | (im & (int)0x80000000); }
        } else win[i] = (int)0x80000000;
    }
    bsort16_desc(win);
#pragma unroll
    for (int lvl = 16; lvl <= 32; lvl <<= 1) {
        int o[16];
#pragma unroll
        for (int i = 0; i < 16; ++i) o[i] = __shfl_xor(win[15 - i], lvl);
#pragma unroll
        for (int i = 0; i < 16; ++i) win[i] = max(win[i], o[i]);
        bmerge16_desc(win);
    }
    const float v0 = sort2f(win[0] & ~255);
    float ev[16], den = 0.f;
#pragma unroll
    for (int r = 0; r < 16; ++r) { ev[r] = __expf(sort2f(win[r] & ~255) - v0); den += ev[r]; }
    const float rden = 1.f / den;
    if (lq == 0) {
#pragma unroll
        for (int r = 0; r < 16; ++r) {
            const int e = (scr[l15 * 33 + (win[r] & 15)] & 127) * 128 + (scr[l15 * 33 + 16 + ((win[r] >> 4) & 15)] & 127);
            out(l15, h * 16 + r, e, ev[r] * rden);
        }
    }
    __builtin_amdgcn_fence(__ATOMIC_RELEASE, "wavefront"); __builtin_amdgcn_wave_barrier(); __builtin_amdgcn_fence(__ATOMIC_ACQUIRE, "wavefront");
}
struct TopkOutGlobal { int* EX; float* GT; int tok0; DEVINL void operator()(int tl, int slot, int e, float g) const { EX[(size_t)(tok0 + tl) * 128 + slot] = e; GT[(size_t)(tok0 + tl) * 128 + slot] = g; } };
struct TopkOutLds { unsigned short* ex; float* gt; DEVINL void operator()(int tl, int slot, int e, float g) const { ex[tl * 128 + slot] = (unsigned short)e; gt[tl * 128 + slot] = g; } };
DEVINL void phase_topk(const Params& p, int layer, int row_lo, int row_hi, char* smem) {
    const int tid = threadIdx.x, lane = tid & 63, wid = tid >> 6;
    int* scr = (int*)smem + wid * 544;
    const bf16_t* Qp = (const bf16_t*)(p.ws + WS_R4);
    const bf16_t* keys = (const bf16_t*)(p.ws + WS_KEYS) + (size_t)layer * 8 * 2 * 128 * 128;
    int* EX = (int*)(p.ws + WS_R2); float* GT = (float*)(p.ws + WS_R2 + (size_t)TALL * 128 * 4);
    const int ntask = ((row_hi - row_lo) / 16) * 8, gw = blockIdx.x * NWAVES + wid, ngw = gridDim.x * NWAVES;
    topk_pairs_init(smem); const int* pab = (const int*)(smem + TOPK_PTAB_OFF);
    for (int task = gw; task < ntask; task += ngw) {
        const int h = task & 7, tok0 = row_lo + (task >> 3) * 16;
        TopkQ Q;
        topk_task<128, TopkOutGlobal, false>(Q, Qp + (size_t)(tok0 + (lane & 15)) * 2048 + h * 256 + (lane >> 4) * 8, keys + (size_t)h * 2 * 128 * 128, h, scr, lane, pab, TopkOutGlobal{EX, GT, tok0});
    }
}

constexpr float U8_SCALE = 1024.f, V8_SCALE = 32.f;
typedef float f32x2v __attribute__((ext_vector_type(2)));
DEVINL void dec16(const u32x4 w, float* t) {
    f32x2v r;
    r = __builtin_amdgcn_cvt_pk_f32_fp8((int)w.x, false); t[0] = r.x; t[1] = r.y; r = __builtin_amdgcn_cvt_pk_f32_fp8((int)w.x, true); t[2] = r.x; t[3] = r.y;
    r = __builtin_amdgcn_cvt_pk_f32_fp8((int)w.y, false); t[4] = r.x; t[5] = r.y; r = __builtin_amdgcn_cvt_pk_f32_fp8((int)w.y, true); t[6] = r.x; t[7] = r.y;
    r = __builtin_amdgcn_cvt_pk_f32_fp8((int)w.z, false); t[8] = r.x; t[9] = r.y; r = __builtin_amdgcn_cvt_pk_f32_fp8((int)w.z, true); t[10] = r.x; t[11] = r.y;
    r = __builtin_amdgcn_cvt_pk_f32_fp8((int)w.w, false); t[12] = r.x; t[13] = r.y; r = __builtin_amdgcn_cvt_pk_f32_fp8((int)w.w, true); t[14] = r.x; t[15] = r.y;
}
DEVINL float clamp8(float x) { return fminf(fmaxf(x, -448.f), 448.f); }
DEVINL void convert_flat_fp8(const float* src, unsigned char* dst, size_t n, float scale) {
    const size_t nth = (size_t)gridDim.x * NTHREADS;
    for (size_t i = (size_t)blockIdx.x * NTHREADS + threadIdx.x; i < n / 16; i += nth) {
        u32x4 o;
#pragma unroll
        for (int q = 0; q < 4; ++q) {
            const f32x4 a = *(const f32x4*)(src + i * 16 + q * 4);
            int w = 0;
            w = __builtin_amdgcn_cvt_pk_fp8_f32(clamp8(a.x * scale), clamp8(a.y * scale), w, false);
            w = __builtin_amdgcn_cvt_pk_fp8_f32(clamp8(a.z * scale), clamp8(a.w * scale), w, true);
            o[q] = (unsigned)w;
        }
        *(u32x4*)(dst + i * 16) = o;
    }
}
DEVINL void convert_v_sliced_fp8(const float* src, unsigned char* dst, float scale) {
    const size_t nth = (size_t)gridDim.x * NTHREADS, nitems = (size_t)16384 * 1024 / 16;
    for (size_t i = (size_t)blockIdx.x * NTHREADS + threadIdx.x; i < nitems; i += nth) {
        u32x4 o;
#pragma unroll
        for (int q = 0; q < 4; ++q) {
            const f32x4 a = *(const f32x4*)(src + i * 16 + q * 4);
            int w = 0;
            w = __builtin_amdgcn_cvt_pk_fp8_f32(clamp8(a.x * scale), clamp8(a.y * scale), w, false);
            w = __builtin_amdgcn_cvt_pk_fp8_f32(clamp8(a.z * scale), clamp8(a.w * scale), w, true);
            o[q] = (unsigned)w;
        }
        const size_t e = i >> 6; const int c0 = (int)(i & 63) * 16;
        *(u32x4*)(dst + (size_t)(c0 >> 7) * ((size_t)16384 * 128) + e * 128 + (c0 & 127)) = o;
    }
}
DEVINL unsigned char* tab8(const Params& p, int layer) { return (unsigned char*)p.out + (layer == 0 ? (size_t)0 : (size_t)96 * MiB); }
DEVINL void vslice_token(const unsigned char* V8s, int lane, int id0, int id1, float h0, float h1, float* acc2  ) {
    const int es = lane >> 3, ck = lane & 7;
    float acc[16];
#pragma unroll
    for (int i = 0; i < 16; ++i) acc[i] = 0.f;
    u32x4 w[16]; float hh[16];
#pragma unroll
    for (int grp = 0; grp < 16; ++grp) {
        const int src = (grp & 7) * 8 + es;
        const int e = __shfl(grp < 8 ? id0 : id1, src); hh[grp] = __shfl(grp < 8 ? h0 : h1, src);
        w[grp] = *(const u32x4*)(V8s + (size_t)e * 128 + ck * 16);
    }
#pragma unroll
    for (int grp = 0; grp < 16; ++grp) {
        float t[16]; dec16(w[grp], t);
#pragma unroll
        for (int i = 0; i < 16; ++i) acc[i] += hh[grp] * t[i];
        __builtin_amdgcn_sched_barrier(0);
    }
    const bool b5 = (lane & 32) != 0, b4 = (lane & 16) != 0, b3 = (lane & 8) != 0;
    float a8[8], a4[4];
#pragma unroll
    for (int i = 0; i < 8; ++i) { const float keep = b5 ? acc[i + 8] : acc[i], send = b5 ? acc[i] : acc[i + 8]; a8[i] = keep + __shfl_xor(send, 32); }
#pragma unroll
    for (int i = 0; i < 4; ++i) { const float keep = b4 ? a8[i + 4] : a8[i], send = b4 ? a8[i] : a8[i + 4]; a4[i] = keep + __shfl_xor(send, 16); }
#pragma unroll
    for (int i = 0; i < 2; ++i) { const float keep = b3 ? a4[i + 2] : a4[i], send = b3 ? a4[i] : a4[i + 2]; acc2[i] = keep + __shfl_xor(send, 8); }
}
DEVINL void phase_peer_v(const Params& p, int layer, int nrows) {
    typedef float f32x2 __attribute__((ext_vector_type(2)));
    const int lane = threadIdx.x & 63, wid = threadIdx.x >> 6;
    const int k = blockIdx.x & 7, j = blockIdx.x >> 3, nj = gridDim.x >> 3;
    const unsigned char* V8s = tab8(p, layer) + (size_t)16384 * 1024 + (size_t)k * ((size_t)16384 * 128);
    const int* EX = (const int*)(p.ws + WS_R2); const float* HC = (const float*)(p.ws + WS_R2 + (size_t)33 * MiB);
    float* XR = (float*)(p.ws + WS_XR);
    const int col = k * 128 + (lane & 7) * 16 + ((lane & 32) ? 8 : 0) + ((lane & 16) ? 4 : 0) + ((lane & 8) ? 2 : 0);
    if (nj == 0 || j >= nj) return;
    int row = j * 8 + wid;
    int nid0 = 0, nid1 = 0; float nh0 = 0.f, nh1 = 0.f;
    if (row < nrows) { nid0 = EX[(size_t)row * 128 + lane]; nid1 = EX[(size_t)row * 128 + 64 + lane]; nh0 = HC[(size_t)row * 128 + lane]; nh1 = HC[(size_t)row * 128 + 64 + lane]; }
    for (; row < nrows; row += nj * 8) {
        float a2[2];
        const int id0 = nid0, id1 = nid1; const float h0 = nh0, h1 = nh1;
        const int nrow = row + nj * 8;
        if (nrow < nrows) { nid0 = EX[(size_t)nrow * 128 + lane]; nid1 = EX[(size_t)nrow * 128 + 64 + lane]; nh0 = HC[(size_t)nrow * 128 + lane]; nh1 = HC[(size_t)nrow * 128 + 64 + lane]; }
        vslice_token(V8s, lane, id0, id1, h0, h1, a2);
        const f32x2 g2 = *(const f32x2*)(mod_ptr(p, layer, row_bb(row), 5) + col);
        f32x2* xp = (f32x2*)(XR + (size_t)row * DM + col);
        const f32x2 x = *xp;
        *xp = (f32x2){x.x + g2.x * a2[0], x.y + g2.y * a2[1]};
    }
}
constexpr int TAIL_SLOTS = 232 + 240 + 224;
constexpr size_t TAB_ITEMS = (size_t)16384 * 1024 / 16;
DEVINL void convert_items(const Params& p, size_t it_lo, size_t it_hi) {
    for (size_t g = it_lo + threadIdx.x; g < it_hi; g += NTHREADS) {
        const int layer = (int)(g / (2 * TAB_ITEMS)); const size_t rem = g % (2 * TAB_ITEMS); const int isv = (int)(rem / TAB_ITEMS); const size_t i = rem % TAB_ITEMS;
        const float* src = (isv ? p.in[21] : p.in[20]) + (size_t)layer * 16384 * 1024 + i * 16; const float scale = isv ? V8_SCALE : U8_SCALE;
        u32x4 o;
#pragma unroll
        for (int q = 0; q < 4; ++q) {
            const f32x4 a = *(const f32x4*)(src + q * 4);
            int w = 0;
            w = __builtin_amdgcn_cvt_pk_fp8_f32(clamp8(a.x * scale), clamp8(a.y * scale), w, false);
            w = __builtin_amdgcn_cvt_pk_fp8_f32(clamp8(a.z * scale), clamp8(a.w * scale), w, true);
            o[q] = (unsigned)w;
        }
        const size_t e = i >> 6; const int c0 = (int)(i & 63) * 16;
        *(u32x4*)(tab8(p, layer) + (size_t)isv * 16384 * 1024 + (size_t)(c0 >> 7) * ((size_t)16384 * 128) + e * 128 + (c0 & 127)) = o;
    }
}
DEVINL void tail_convert(const Params& p, int n_units, int slot_base) {
    if (gridDim.x != 256) return;
    const int rem = n_units % 256;
    if ((int)blockIdx.x < rem) return;
    const int slot = slot_base + (int)blockIdx.x - rem;
    const size_t per = (4 * TAB_ITEMS + TAIL_SLOTS - 1) / TAIL_SLOTS;
    const size_t lo = (size_t)slot * per, hi = lo + per < 4 * TAB_ITEMS ? lo + per : 4 * TAB_ITEMS;
    if (lo < hi) convert_items(p, lo, hi);
}
DEVINL void phase_final_norm(const Params& p) {
    const int lane = threadIdx.x & 63, gw = blockIdx.x * NWAVES + (threadIdx.x >> 6), ngw = gridDim.x * NWAVES;
    const float* XR = (const float*)(p.ws + WS_XR);
    f32x4 nv[4];
    if (gw < TLAT) {
#pragma unroll
        for (int jq = 0; jq < 4; ++jq) nv[jq] = *(const f32x4*)(XR + (size_t)gw * DM + (jq * 64 + lane) * 4);
    }
    for (int row = gw; row < TLAT; row += ngw) {
        f32x4 v[4]; float ss = 0.f;
#pragma unroll
        for (int jq = 0; jq < 4; ++jq) { v[jq] = nv[jq]; ss += (v[jq].x * v[jq].x + v[jq].y * v[jq].y) + (v[jq].z * v[jq].z + v[jq].w * v[jq].w); }
        if (row + ngw < TLAT) {
#pragma unroll
            for (int jq = 0; jq < 4; ++jq) nv[jq] = *(const f32x4*)(XR + (size_t)(row + ngw) * DM + (jq * 64 + lane) * 4);
        }
        const float rinv = rsqrtf(wave_sum(ss) * (1.f / DM) + EPS);
#pragma unroll
        for (int jq = 0; jq < 4; ++jq) { const int c = (jq * 64 + lane) * 4; const f32x4 g = *(const f32x4*)(p.in[22] + c); *(f32x4*)(p.out + (size_t)row * DM + c) = v[jq] * rinv * g; }
    }
}
constexpr int KEY_LS = 136;
DEVINL void phase_peer_topk(const Params& p, int layer, char* smem) {
    const int tid = threadIdx.x, lane = tid & 63, wid = __builtin_amdgcn_readfirstlane(tid >> 6);
    int* scr = (int*)smem + wid * 544;
    bf16_t* skeys = (bf16_t*)(smem + 20480);
    const bf16_t* Qp = (const bf16_t*)(p.ws + WS_R4);
    const bf16_t* keys = (const bf16_t*)(p.ws + WS_KEYS) + (size_t)layer * 8 * 2 * 128 * 128;
    int* EX = (int*)(p.ws + WS_R2); float* GT = (float*)(p.ws + WS_R2 + (size_t)TALL * 128 * 4);
    topk_pairs_init(smem); const int* pab = (const int*)(smem + TOPK_PTAB_OFF);
    for (int sb = blockIdx.x; sb < TLAT / 128; sb += gridDim.x) {
        const int tok0 = sb * 128 + wid * 16;
        TopkQ Q; topk_load_q(Qp, tok0, 0, lane, Q);
#pragma unroll 1
        for (int h = 0; h < 8; ++h) {
            __syncthreads();
            {
                const int r = tid >> 1, hf = tid & 1;
                const u32x4* src = (const u32x4*)(keys + ((size_t)h * 256 + r) * 128 + hf * 64);
                u32x4* dst = (u32x4*)(skeys + (size_t)r * KEY_LS + hf * 64);
#pragma unroll
                for (int i = 0; i < 8; ++i) dst[i] = src[i];
            }
            __syncthreads();
            topk_task<KEY_LS, TopkOutGlobal, true>(Q, nullptr, skeys, h, scr, lane, pab, TopkOutGlobal{EX, GT, tok0}, h < 7 ? Qp : nullptr, tok0);
        }
    }
}
DEVINL void phase_peer_u_sliced(const Params& p, int layer, int nrows) {
    typedef long i64x2 __attribute__((ext_vector_type(2)));
    const int lane = threadIdx.x & 63, wid = threadIdx.x >> 6, l15 = lane & 15, lq = lane >> 4;
    const int k = blockIdx.x & 7, j = blockIdx.x >> 3, nj = gridDim.x >> 3;
    if (nj == 0 || j >= nj) return;
    const int es = l15 >> 1, ck = 2 * lq + (l15 & 1), rep = (lane & 1) + 2 * lq;
    const bool odd = (l15 & 1) != 0;
    const unsigned char* U8s = tab8(p, layer) + (size_t)k * ((size_t)16384 * 128);
    const unsigned char* F8 = (const unsigned char*)p.out + (size_t)32 * MiB + k * 128 + ck * 16;
    const int* EX = (const int*)(p.ws + WS_R2);
    float* PD = (float*)(p.ws + WS_R4) + (size_t)k * ((size_t)TALL * 128);
    const int step = nj * 8;
    int row = j * 8 + wid;
    if (row >= nrows) return;
    int nid0 = EX[(size_t)row * 128 + lane], nid1 = EX[(size_t)row * 128 + 64 + lane];
    i64x2 nf = *(const i64x2*)(F8 + (size_t)row * DM);
    for (; row < nrows; row += step) {
        const int id0 = nid0, id1 = nid1; const i64x2 fv = nf;
        const int nrow = row + step;
        if (nrow < nrows) { nid0 = EX[(size_t)nrow * 128 + lane]; nid1 = EX[(size_t)nrow * 128 + 64 + lane]; nf = *(const i64x2*)(F8 + (size_t)nrow * DM); }
        i64x2 w[16];
#pragma unroll
        for (int g = 0; g < 16; ++g) { const int e = __shfl(g < 8 ? id0 : id1, (g & 7) * 8 + es); w[g] = *(const i64x2*)(U8s + (size_t)e * 128 + ck * 16); }
        float keep0 = 0.f, keep1 = 0.f;
#pragma unroll
        for (int g = 0; g < 16; ++g) {
            f32x4 acc = (f32x4){0.f, 0.f, 0.f, 0.f};
            acc = __builtin_amdgcn_mfma_f32_16x16x32_fp8_fp8(fv.x, w[g].x, acc, 0, 0, 0);
            acc = __builtin_amdgcn_mfma_f32_16x16x32_fp8_fp8(fv.y, w[g].y, acc, 0, 0, 0);
            float v = odd ? acc[1] : acc[0];
            v += __int_as_float(__builtin_amdgcn_mov_dpp(__float_as_int(v), 0xB1, 0xF, 0xF, true));
            const bool mine = rep == (g & 7);
            if (g < 8) keep0 = mine ? v : keep0; else keep1 = mine ? v : keep1;
        }
        PD[(size_t)row * 128 + rep * 8 + es] = keep0; PD[(size_t)row * 128 + 64 + rep * 8 + es] = keep1;
    }
}
DEVINL void phase_peer_reduce(const Params& p, int nrows) {
    const int lane = threadIdx.x & 63, gw = blockIdx.x * NWAVES + (threadIdx.x >> 6), ngw = gridDim.x * NWAVES;
    const float* PD = (const float*)(p.ws + WS_R4); const float* GT = (const float*)(p.ws + WS_R2 + (size_t)TALL * 128 * 4);
    float* HC = (float*)(p.ws + WS_R2 + (size_t)33 * MiB);
    const float inv = 1.f / (U8_SCALE * F8_SCALE);
    for (int row = gw; row < nrows; row += ngw) {
        float s0 = 0.f, s1 = 0.f;
#pragma unroll
        for (int kk = 0; kk < 8; ++kk) { s0 += PD[((size_t)kk * TALL + row) * 128 + lane]; s1 += PD[((size_t)kk * TALL + row) * 128 + 64 + lane]; }
        HC[(size_t)row * 128 + lane] = GT[(size_t)row * 128 + lane] * gelu_f(s0 * inv) * (1.f / V8_SCALE);
        HC[(size_t)row * 128 + 64 + lane] = GT[(size_t)row * 128 + 64 + lane] * gelu_f(s1 * inv) * (1.f / V8_SCALE);
    }
}

DEVINL float logsig_fast(float x) { return fminf(x, 0.f) - __logf(1.f + __expf(-fabsf(x))); }
DEVINL void phase_gla_prep(const Params& p, char* smem) {
    float* sG = (float*)smem;
    float* sTot = sG + 64 * 32;
    const int tid = threadIdx.x, dp = tid & 63, tq = tid >> 6;
    typedef float f32x2 __attribute__((ext_vector_type(2)));
    const float* G = (const float*)(p.ws + WS_G);
    const bf16_t* QK = (const bf16_t*)(p.ws + WS_R3);
    bf16_t* QREL[2] = {(bf16_t*)(p.ws + WS_R1), (bf16_t*)(p.ws + WS_R2)};
    bf16_t* KEND[2] = {(bf16_t*)(p.ws + WS_R1 + SZ_HALF_R), (bf16_t*)(p.ws + WS_R2 + SZ_HALF_R)};
    float* DEND = (float*)(p.ws + WS_DEND);
    const float* gw_ = p.in[14]; const float* gb_ = p.in[15];
    for (int u = blockIdx.x; u < 528 * 4; u += gridDim.x) {
        const int cidx = u >> 2, h = u & 3, row0 = cidx * 64, ch = h * 128 + 2 * dp;
        __syncthreads();
        *(f32x4*)(sG + tid * 4) = *(const f32x4*)(G + (size_t)row0 * 32 + tid * 4);
        unsigned qraw[8], kraw[8];
#pragma unroll
        for (int i = 0; i < 8; ++i) { const size_t row = (size_t)row0 + tq * 8 + i; qraw[i] = *(const unsigned*)(QK + row * 1024 + ch); kraw[i] = *(const unsigned*)(QK + row * 1024 + 512 + ch); }
        __syncthreads();
        float lg[2][8][2];
#pragma unroll
        for (int dir = 0; dir < 2; ++dir) {
            f32x2 w[16];
#pragma unroll
            for (int j = 0; j < 16; ++j) w[j] = *(const f32x2*)(gw_ + (dir * 16 + j) * 512 + ch);
            const f32x2 bias = *(const f32x2*)(gb_ + dir * 512 + ch);
            float t0 = 0.f, t1 = 0.f;
#pragma unroll
            for (int i = 0; i < 8; ++i) {
                const float* gr = sG + (tq * 8 + i) * 32 + dir * 16;
                float x0 = bias.x, x1 = bias.y;
#pragma unroll
                for (int j = 0; j < 16; ++j) { x0 += gr[j] * w[j].x; x1 += gr[j] * w[j].y; }
                lg[dir][i][0] = logsig_fast(x0) * (1.f / 16.f); lg[dir][i][1] = logsig_fast(x1) * (1.f / 16.f);
                t0 += lg[dir][i][0]; t1 += lg[dir][i][1];
            }
            *(f32x2*)(sTot + (dir * 8 + tq) * 128 + 2 * dp) = (f32x2){t0, t1};
        }
        __syncthreads();
#pragma unroll
        for (int dir = 0; dir < 2; ++dir) {
            float be0 = 0.f, be1 = 0.f, r0 = 0.f, r1 = 0.f;
#pragma unroll
            for (int q = 0; q < 8; ++q) {
                const f32x2 t = *(const f32x2*)(sTot + (dir * 8 + q) * 128 + 2 * dp);
                be0 += t.x; be1 += t.y;
                const bool inc = dir == 0 ? (q < tq) : (q > tq);
                r0 += inc ? t.x : 0.f; r1 += inc ? t.y : 0.f;
            }
#pragma unroll
            for (int ii = 0; ii < 8; ++ii) {
                const int i = dir == 0 ? ii : 7 - ii;
                r0 += lg[dir][i][0]; r1 += lg[dir][i][1];
                const size_t row = (size_t)row0 + tq * 8 + i;
                const float q0 = bf2f(qraw[i] & 0xffff), q1 = bf2f(qraw[i] >> 16), k0 = bf2f(kraw[i] & 0xffff), k1 = bf2f(kraw[i] >> 16);
                *(unsigned*)(QREL[dir] + row * 512 + ch) = pk2(q0 * 0.08838834764831845f * __expf(r0 - be0), q1 * 0.08838834764831845f * __expf(r1 - be1));
                *(unsigned*)(KEND[dir] + row * 512 + ch) = pk2(k0 * __expf(be0 - r0), k1 * __expf(be1 - r1));
            }
            if (tq == 0) *(f32x2*)(DEND + ((size_t)dir * 528 + cidx) * 512 + ch) = (f32x2){__expf(be0), __expf(be1)};
        }
    }
}

constexpr int C_QS = 136, C_TS = 72;
#define LDS_BARRIER() do { asm volatile("s_waitcnt lgkmcnt(0)" ::: "memory"); __builtin_amdgcn_s_barrier(); asm volatile("" ::: "memory"); } while (0)
DEVINL void phase_gla_chain(const Params& p, char* smem) {
    constexpr int CH_BUF = (64 * C_QS * 2 + 128 * C_TS + 32 * C_TS) * 2 + 512;
    bf16_t* sSdT = (bf16_t*)(smem + 2 * CH_BUF);
    bf16_t* sP = sSdT + 32 * C_QS;
    const int tid = threadIdx.x, lane = tid & 63, w = tid >> 6, l15 = lane & 15, lq = lane >> 4;
    const bf16_t* VR = (const bf16_t*)(p.ws + WS_R4);
    const float* DEND = (const float*)(p.ws + WS_DEND);
    const int G = gridDim.x, vcu = (G % 8 == 0) ? (blockIdx.x % 8) * (G / 8) + blockIdx.x / 8 : blockIdx.x;
    for (int ch = vcu; ch < 256; ch += G) {
        const int vs = ch & 7, dir = (ch >> 3) & 1, h = (ch >> 4) & 3, b = ch >> 6;
        const bf16_t* QREL = (const bf16_t*)(p.ws + (dir ? WS_R2 : WS_R1));
        const bf16_t* KEND = (const bf16_t*)(p.ws + (dir ? WS_R2 : WS_R1) + SZ_HALF_R);
        bf16_t* OD = dir ? (bf16_t*)((unsigned char*)p.out + (size_t)32 * MiB) : (bf16_t*)(p.ws + WS_R3);
        f32x4 S[2]; S[0] = (f32x4){0.f, 0.f, 0.f, 0.f}; S[1] = S[0];
#define CH_ROW0(n_) ((n_) < 4 ? TLAT + b * CTX + 64 * (dir ? 3 - (n_) : (n_)) : b * SEQ + 64 * (dir ? 127 - ((n_) - 4) : (n_) - 4))
#define CH_LOAD(n_) do { const int r0_ = CH_ROW0(n_); \
            _Pragma("unroll") for (int i = 0; i < 2; ++i) { const int chn = tid + i * NTHREADS, r = chn >> 4, c16 = chn & 15; \
                pq[i] = *(const u32x4*)(QREL + (size_t)(r0_ + r) * 512 + h * 128 + c16 * 8); pk[i] = *(const u32x4*)(KEND + (size_t)(r0_ + r) * 512 + h * 128 + c16 * 8); } \
            if (tid < 256) pvv = *(const u32x4*)(VR + (size_t)(r0_ + (tid >> 2)) * 2048 + h * 256 + vs * 32 + (tid & 3) * 8); \
            if (tid < 128) pd = DEND[((size_t)dir * 528 + (r0_ >> 6)) * 512 + h * 128 + tid]; } while (0)
#define CH_STAGE(buf_) do { bf16_t* sQ_ = (bf16_t*)(smem + (buf_) * CH_BUF); bf16_t* sK_ = sQ_ + 64 * C_QS; bf16_t* sKT_ = sK_ + 64 * C_QS; bf16_t* sVT_ = sKT_ + 128 * C_TS; float* sD_ = (float*)(sVT_ + 32 * C_TS); \
            _Pragma("unroll") for (int i = 0; i < 2; ++i) { const int chn = tid + i * NTHREADS, r = chn >> 4, c16 = chn & 15; const u32x4 qv = pq[i], kv = pk[i]; \
                *(u32x4*)(sQ_ + r * C_QS + c16 * 8) = qv; *(u32x4*)(sK_ + r * C_QS + c16 * 8) = kv; \
                bf16_t* kt = sKT_ + (c16 * 8) * C_TS + ((((r >> 3) ^ (c16 & 7)) << 3) | (r & 7));       \
                kt[0] = (bf16_t)(kv.x & 0xffff); kt[C_TS] = (bf16_t)(kv.x >> 16); kt[2 * C_TS] = (bf16_t)(kv.y & 0xffff); kt[3 * C_TS] = (bf16_t)(kv.y >> 16); \
                kt[4 * C_TS] = (bf16_t)(kv.z & 0xffff); kt[5 * C_TS] = (bf16_t)(kv.z >> 16); kt[6 * C_TS] = (bf16_t)(kv.w & 0xffff); kt[7 * C_TS] = (bf16_t)(kv.w >> 16); } \
            if (tid < 256) { const int r = tid >> 2, c = tid & 3; const u32x4 vv = pvv; bf16_t* vt = sVT_ + (c * 8) * C_TS + ((((r >> 3) ^ c) << 3) | (r & 7)); \
                vt[0] = (bf16_t)(vv.x & 0xffff); vt[C_TS] = (bf16_t)(vv.x >> 16); vt[2 * C_TS] = (bf16_t)(vv.y & 0xffff); vt[3 * C_TS] = (bf16_t)(vv.y >> 16); \
                vt[4 * C_TS] = (bf16_t)(vv.z & 0xffff); vt[5 * C_TS] = (bf16_t)(vv.z >> 16); vt[6 * C_TS] = (bf16_t)(vv.w & 0xffff); vt[7 * C_TS] = (bf16_t)(vv.w >> 16); } \
            if (tid < 128) sD_[tid] = pd; } while (0)
        u32x4 pq[2], pk[2], pvv = (u32x4){0u, 0u, 0u, 0u}; float pd = 0.f;
        LDS_BARRIER();
        CH_LOAD(0); CH_STAGE(0); CH_LOAD(1);
        LDS_BARRIER();
        for (int n = 0; n < 132; ++n) {
            const int row0 = CH_ROW0(n); const bool lat = n >= 4;
            const bf16_t* sQ = (const bf16_t*)(smem + (n & 1) * CH_BUF); const bf16_t* sK = sQ + 64 * C_QS; const bf16_t* sKT = sK + 64 * C_QS; const bf16_t* sVT = sKT + 128 * C_TS; const float* sD = (const float*)(sVT + 32 * C_TS);
            const int ct = w >> 1, ntw = w & 1;
            {
                const f32x4 dv = *(const f32x4*)(sD + 16 * w + lq * 4);
#pragma unroll
                for (int nt = 0; nt < 2; ++nt) {
                    S[nt] = S[nt] * dv;
                    u32x2 o; o.x = pk2(S[nt].x, S[nt].y); o.y = pk2(S[nt].z, S[nt].w);
                    *(u32x2*)(sSdT + (nt * 16 + l15) * C_QS + 16 * w + lq * 4) = o;
                }
            }
            bf16x8 qf[4];
#pragma unroll
            for (int kk = 0; kk < 4; ++kk) qf[kk] = *(const bf16x8*)(sQ + (ct * 16 + l15) * C_QS + kk * 32 + lq * 8);
#pragma unroll
            for (int si = 0; si < 2; ++si) {
                const int st = 2 * ntw + si;
                f32x4 a = (f32x4){0.f, 0.f, 0.f, 0.f};
#pragma unroll
                for (int kk = 0; kk < 4; ++kk) {
                    const bf16x8 ka = *(const bf16x8*)(sK + (st * 16 + l15) * C_QS + kk * 32 + lq * 8);
                    a = __builtin_amdgcn_mfma_f32_16x16x32_bf16(ka, qf[kk], a, 0, 0, 0);
                }
                const int c = ct * 16 + l15, s0 = st * 16 + lq * 4;
                float pv[4];
#pragma unroll
                for (int j = 0; j < 4; ++j) { const int sx = s0 + j; const bool keep = dir ? (sx >= c) : (sx <= c); pv[j] = keep ? a[j] : 0.f; }
                u32x2 o; o.x = pk2(pv[0], pv[1]); o.y = pk2(pv[2], pv[3]);
                *(u32x2*)(sP + c * C_TS + s0) = o;
            }
            LDS_BARRIER();
            bf16x8 vf[2];
#pragma unroll
            for (int ss = 0; ss < 2; ++ss) vf[ss] = *(const bf16x8*)(sVT + (ntw * 16 + l15) * C_TS + (((ss * 4 + lq) ^ ((2 * ntw + (l15 >> 3)) & 3)) << 3));
            {
                f32x4 a = (f32x4){0.f, 0.f, 0.f, 0.f};
#pragma unroll
                for (int ss = 0; ss < 2; ++ss) {
                    const bf16x8 pb = *(const bf16x8*)(sP + (ct * 16 + l15) * C_TS + ss * 32 + lq * 8);
                    a = __builtin_amdgcn_mfma_f32_16x16x32_bf16(vf[ss], pb, a, 0, 0, 0);
                }
#pragma unroll
                for (int kk = 0; kk < 4; ++kk) {
                    const bf16x8 sa = *(const bf16x8*)(sSdT + (ntw * 16 + l15) * C_QS + kk * 32 + lq * 8);
                    a = __builtin_amdgcn_mfma_f32_16x16x32_bf16(sa, qf[kk], a, 0, 0, 0);
                }
                if (lat) {
                    u32x2 o; o.x = pk2(a.x, a.y); o.y = pk2(a.z, a.w);
                    *(u32x2*)(OD + (size_t)(row0 + ct * 16 + l15) * 1024 + h * 256 + vs * 32 + ntw * 16 + lq * 4) = o;
                }
            }
            {
                bf16x8 kf[2];
#pragma unroll
                for (int ss = 0; ss < 2; ++ss) kf[ss] = *(const bf16x8*)(sKT + (16 * w + l15) * C_TS + (((ss * 4 + lq) ^ ((2 * w + (l15 >> 3)) & 7)) << 3));
#pragma unroll
                for (int nt = 0; nt < 2; ++nt)
#pragma unroll
                    for (int ss = 0; ss < 2; ++ss) {
                        const bf16x8 vb = (nt == ntw) ? vf[ss] : *(const bf16x8*)(sVT + (nt * 16 + l15) * C_TS + (((ss * 4 + lq) ^ ((2 * nt + (l15 >> 3)) & 3)) << 3));
                        S[nt] = __builtin_amdgcn_mfma_f32_16x16x32_bf16(kf[ss], vb, S[nt], 0, 0, 0);
                    }
            }
            if (n + 1 < 132) { CH_STAGE((n + 1) & 1); if (n + 2 < 132) CH_LOAD(n + 2); }
            LDS_BARRIER();
        }
    }
}
#undef CH_STAGE
#undef CH_ROW0
#undef CH_LOAD
DEVINL void phase_gla_post(const Params& p) {
    const int lane = threadIdx.x & 63, gw = blockIdx.x * NWAVES + (threadIdx.x >> 6), ngw = gridDim.x * NWAVES;
    const bf16_t* OF = (const bf16_t*)(p.ws + WS_R3); const bf16_t* OB = (const bf16_t*)((const unsigned char*)p.out + (size_t)32 * MiB);
    const bf16_t* VR = (const bf16_t*)(p.ws + WS_R4);
    unsigned char* Y = p.ws + WS_R1;
    const f32x4 hg = *(const f32x4*)(p.in[16] + lane * 4);
    for (int row = gw; row < TLAT; row += ngw) {
#pragma unroll
        for (int h = 0; h < 4; ++h) {
            const int c = h * 256 + lane * 4;
            const u32x2 a = *(const u32x2*)(OF + (size_t)row * 1024 + c), b = *(const u32x2*)(OB + (size_t)row * 1024 + c), r = *(const u32x2*)(VR + (size_t)row * 2048 + 1024 + c);
            const float o0 = bf2f(a.x & 0xffff) + bf2f(b.x & 0xffff), o1 = bf2f(a.x >> 16) + bf2f(b.x >> 16), o2 = bf2f(a.y & 0xffff) + bf2f(b.y & 0xffff), o3 = bf2f(a.y >> 16) + bf2f(b.y >> 16);
            const float rinv = rsqrtf(wave_sum((o0 * o0 + o1 * o1) + (o2 * o2 + o3 * o3)) * (1.f / 256.f) + EPS);
#define Y8C(v_) fminf(fmaxf((v_) * Y8_SCALE, -448.f), 448.f)
            int y = 0; y = __builtin_amdgcn_cvt_pk_fp8_f32(Y8C(o0 * rinv * hg.x * silu_f(bf2f(r.x & 0xffff))), Y8C(o1 * rinv * hg.y * silu_f(bf2f(r.x >> 16))), y, false);
            y = __builtin_amdgcn_cvt_pk_fp8_f32(Y8C(o2 * rinv * hg.z * silu_f(bf2f(r.y & 0xffff))), Y8C(o3 * rinv * hg.w * silu_f(bf2f(r.y >> 16))), y, true);
#undef Y8C
            *(int*)(Y + (size_t)row * 1024 + c) = y;
        }
    }
}

#define GAS __attribute__((address_space(1)))
#define LAS __attribute__((address_space(3)))
#define XB_TMO      128
#define XB_XCNT(j)  (256  + 64 * (j))
#define XB_XSUB(j)  (1280 + 64 * (j))
#define XB_XGEN(j)  (2304 + 64 * (j))
#define XB_TOP      3328
#define XB_TOPGEN   3392
#define XCD_BAR_WORDS 3456
#define XB_SPIN_CAP (1u << 18)

__device__ __forceinline__ unsigned xb_ld(unsigned* p)              { return __hip_atomic_load(p, __ATOMIC_RELAXED, __HIP_MEMORY_SCOPE_AGENT); }
__device__ __forceinline__ unsigned xb_add(unsigned* p, unsigned v) { return __hip_atomic_fetch_add(p, v, __ATOMIC_RELAXED, __HIP_MEMORY_SCOPE_AGENT); }
__device__ __forceinline__ unsigned xb_xcc_id() { return (unsigned)__builtin_amdgcn_s_getreg((3 << 11) | 20) & 0xFu; }
#define XB_SPIN(cond, bar) do { unsigned _sp = 0; while (cond) { __builtin_amdgcn_s_sleep(1); \
    if ((++_sp & 255u) == 0u) { if (xb_ld(&(bar)[XB_TMO])) break; if (_sp > XB_SPIN_CAP) { atomicAdd(&(bar)[XB_TMO], 1u); break; } } } } while (0)

struct XcdBarrier {
    unsigned* bar; unsigned x;
    volatile LAS unsigned* st;
};

__device__ __forceinline__ XcdBarrier xcd_barrier_post(unsigned* bar, volatile LAS unsigned* st) {
    XcdBarrier b; b.bar = bar; b.x = xb_xcc_id(); b.st = st;
    if (threadIdx.x == 0) (void)xb_add(&bar[XB_XCNT(b.x)], 1u);
    return b;
}
__device__ __forceinline__ void xcd_barrier_complete(unsigned* bar, unsigned x, unsigned& nloc, unsigned& nx) {
    const unsigned G = gridDim.x * gridDim.y * gridDim.z;
    unsigned sum, cnt, mine, sp = 0u;
    for (;;) {
        sum = 0u; cnt = 0u; mine = 0u;
#pragma unroll
        for (unsigned j = 0; j < 16; ++j) { const unsigned c = xb_ld(&bar[XB_XCNT(j)]); sum += c; cnt += (c > 0u) ? 1u : 0u; mine = (j == x) ? c : mine; }
        if (sum == G) break;
        __builtin_amdgcn_s_sleep(1);
        if ((++sp & 255u) == 0u) { if (xb_ld(&bar[XB_TMO])) break; if (sp > XB_SPIN_CAP) { atomicAdd(&bar[XB_TMO], 1u); break; } }
    }
    nloc = mine > 0u ? mine : 1u; nx = cnt > 0u ? cnt : 1u;
}

__device__ __forceinline__ void xcd_barrier(const XcdBarrier& b) {
    asm volatile("s_waitcnt vmcnt(0)" ::: "memory");
    __syncthreads();
    if (threadIdx.x == 0) {
        unsigned* bar = b.bar;
        __builtin_amdgcn_s_waitcnt(0);
        unsigned nloc = b.st[0], nx = b.st[1];
        if (nloc == 0u) { xcd_barrier_complete(bar, b.x, nloc, nx); b.st[0] = nloc; b.st[1] = nx; }
        const unsigned old = xb_add(&bar[XB_XSUB(b.x)], 1u);
        const unsigned gen = old / nloc;
        if (old + 1u == (gen + 1u) * nloc) {
            __builtin_amdgcn_fence(__ATOMIC_RELEASE, "agent");
            asm volatile("s_waitcnt vmcnt(0)" ::: "memory");
            const unsigned og = xb_add(&bar[XB_TOP], 1u);
            const unsigned tg = og / nx;
            if (og + 1u == (tg + 1u) * nx) xb_add(&bar[XB_TOPGEN], 1u);
            else XB_SPIN(xb_ld(&bar[XB_TOPGEN]) == tg, bar);
            __builtin_amdgcn_fence(__ATOMIC_ACQUIRE, "agent");
            xb_add(&bar[XB_XGEN(b.x)], 1u);
            asm volatile("s_waitcnt vmcnt(0)" ::: "memory");
        } else {
            XB_SPIN(xb_ld(&bar[XB_XGEN(b.x)]) == gen, bar);
            __builtin_amdgcn_fence(__ATOMIC_ACQUIRE, "agent");
            asm volatile("s_waitcnt vmcnt(0)" ::: "memory");
        }
    }
    __syncthreads();
}
constexpr size_t WS_BAR = 64 * 1024;
constexpr size_t CTL_ZERO_BYTES = 128 * 1024;
constexpr int LDS_MISC_OFF = LDS_BYTES - 64;

#define GEMM_RUN(EPI, EOBJ, Aptr, Bptr, M_, N_) do { pg8::Gemm g_{(const pg8::bf16_t*)(Aptr), (const pg8::bf16_t*)(Bptr), (M_), (N_), DM}; pg8::StaticOrder S_; S_.init((M_), (N_), (int)gridDim.x, (int)blockIdx.x); \
        const EPI E_ = EOBJ; pg8::gemm_phase<EPI, pg8::StaticOrder, true, true>((PG8_LAS unsigned char*)smem, g_, S_, E_); } while (0)
#define GEMM_RUN8(EPI, EOBJ, Aptr, Bptr, M_, N_) do { pg8::Gemm g_{(const pg8::bf16_t*)(Aptr), (const pg8::bf16_t*)(Bptr), (M_), (N_), DM / 2}; pg8::StaticOrder S_; S_.init((M_), (N_), (int)gridDim.x, (int)blockIdx.x); \
        const EPI E_ = EOBJ; pg8::gemm_phase<EPI, pg8::StaticOrder, true, true, true>((PG8_LAS unsigned char*)smem, g_, S_, E_); } while (0)
DEVINL void run_phase(const Params& p, int ph, char* smem) {
    unsigned char* ws = p.ws;
#ifdef ONLY_PHASE
    ph = ONLY_PHASE;
#endif
    switch (ph) {
    case 0: phase_prologue(p, smem);
            if (gridDim.x != 256) { const size_t per = (4 * TAB_ITEMS + gridDim.x - 1) / gridDim.x, lo = blockIdx.x * per, hi = lo + per < 4 * TAB_ITEMS ? lo + per : 4 * TAB_ITEMS; if (lo < hi) convert_items(p, lo, hi); }
            break;
    case 1: phase_norm_mod(p, p.in[0], p.in[2], TALL, p.in[6], 0, 0, 1, nullptr, ws + WS_R1); break;
    case 2: GEMM_RUN8(pg8::EpiStoreBf16, (pg8::EpiStoreBf16{(bf16_t*)(ws + WS_R4), ATTN_IN, 1.f / (F8_SCALE * W8_SCALE)}), ws + WS_R1, ws + WS_WT_ATTN_IN, TALL, ATTN_IN); tail_convert(p, (TALL / 256) * (ATTN_IN / 256), 0); break;
    case 3: phase_qkpost(p); break;
    case 4: phase_attn(p, smem); break;
    case 5: GEMM_RUN8(pg8::EpiResidF32, (pg8::EpiResidF32{p.in[0], p.in[2], (float*)(ws + WS_XR), mod_ptr(p, 0, 0, 2), 1.f / (O8_SCALE * W8_SCALE)}), ws + WS_R4, ws + WS_WT_ATTN_OUT, TALL, DM); tail_convert(p, (TALL / 256) * (DM / 256), 232); break;
    case 6: phase_norm_mod(p, (const float*)(ws + WS_XR), (const float*)(ws + WS_XR) + (size_t)TLAT * DM, TALL, p.in[7], 0, 3, 4, nullptr, (unsigned char*)p.out + (size_t)32 * MiB);
            break;
    case 7: GEMM_RUN8(pg8::EpiStoreBf16, (pg8::EpiStoreBf16{(bf16_t*)(ws + WS_R4), 2048, 1.f / (F8_SCALE * W8_SCALE)}), (unsigned char*)p.out + (size_t)32 * MiB, ws + WS_WT_PQ0, TALL, 2048); tail_convert(p, (TALL / 256) * (2048 / 256), 472); break;
    case 8: break;
    case 9: phase_peer_topk(p, 0, smem); __syncthreads(); phase_topk(p, 0, TLAT, TALL, smem); break;
    case 25: phase_peer_u_sliced(p, 0, TALL); break;
    case 26: phase_peer_reduce(p, TALL); break;
    case 19: phase_peer_v(p, 0, TALL); break;
    case 20: phase_norm_mod(p, (const float*)(ws + WS_XR), (const float*)(ws + WS_XR) + (size_t)TLAT * DM, TALL, p.in[6] + 1024, 1, 0, 1, nullptr, ws + WS_R1); break;
    case 10: GEMM_RUN8(pg8::EpiGla, (pg8::EpiGla{(bf16_t*)(ws + WS_R3), (bf16_t*)(ws + WS_R4), (float*)(ws + WS_G), 1.f / (F8_SCALE * W8_SCALE)}), ws + WS_R1, ws + WS_WT_GLA_IN, TALL, GLA_IN_PAD); break;
    case 11: phase_gla_prep(p, smem); break;
    case 12: phase_gla_chain(p, smem); break;
    case 13: phase_gla_post(p); break;
    case 14: GEMM_RUN8(pg8::EpiResidF32, (pg8::EpiResidF32{(const float*)(ws + WS_XR), (const float*)(ws + WS_XR) + (size_t)TLAT * DM, (float*)(ws + WS_XR), mod_ptr(p, 1, 0, 2), 1.f / (Y8_SCALE * W8_SCALE)}), ws + WS_R1, ws + WS_WT_GLA_OUT, TLAT, DM); break;
    case 15: phase_norm_mod(p, (const float*)(ws + WS_XR), (const float*)(ws + WS_XR) + (size_t)TLAT * DM, TLAT, p.in[7] + 1024, 1, 3, 4, nullptr, (unsigned char*)p.out + (size_t)32 * MiB);
             break;
    case 16: GEMM_RUN8(pg8::EpiStoreBf16, (pg8::EpiStoreBf16{(bf16_t*)(ws + WS_R4), 2048, 1.f / (F8_SCALE * W8_SCALE)}), (unsigned char*)p.out + (size_t)32 * MiB, ws + WS_WT_PQ1, TLAT, 2048); break;
    case 17: break;
    case 18: phase_peer_topk(p, 1, smem); break;
    case 27: phase_peer_u_sliced(p, 1, TLAT); break;
    case 28: phase_peer_reduce(p, TLAT); break;
    case 21: phase_peer_v(p, 1, TLAT); break;
    case 22: phase_final_norm(p); break;
    default: break;
    }
}

__global__ void __launch_bounds__(NTHREADS, 2) fwd_kernel(Params p, int ph_lo, int ph_hi) {
    extern __shared__ __attribute__((aligned(16))) char smem[];
    cg::grid_group grid = cg::this_grid();
    volatile LAS unsigned* misc = (volatile LAS unsigned*)((LAS unsigned char*)smem + LDS_MISC_OFF);
    if (threadIdx.x < 2) misc[threadIdx.x] = 0u;
    __syncthreads();
    (void)xcd_barrier_post((unsigned*)(p.ws + WS_BAR), misc);
#ifndef PROBE_MASK
#define PROBE_MASK 0u
#endif
#define SEAM(k) do { if ((k) == 0) grid.sync(); else { XcdBarrier xb_; xb_.bar = (unsigned*)(p.ws + WS_BAR); xb_.x = xb_xcc_id(); xb_.st = (volatile LAS unsigned*)((LAS unsigned char*)smem + LDS_MISC_OFF); xcd_barrier(xb_); } } while (0)
#define PHASE(k) if (ph_lo <= (k) && (k) < ph_hi) { run_phase(p, (k), smem); if ((PROBE_MASK >> (k)) & 1u) { SEAM(k); run_phase(p, (k), smem); } SEAM(k); }
    PHASE(0) PHASE(1) PHASE(2) PHASE(3) PHASE(4) PHASE(5) PHASE(6) PHASE(7) PHASE(9) PHASE(25) PHASE(26) PHASE(19) PHASE(20)
    PHASE(10) PHASE(11) PHASE(12) PHASE(13) PHASE(14) PHASE(15) PHASE(16) PHASE(18) PHASE(27) PHASE(28) PHASE(21)
    if (ph_lo <= 22 && 22 < ph_hi) run_phase(p, 22, smem);
#undef PHASE
#undef SEAM
}

extern "C" void kernel_launch(void* const* d_in, const int* in_sizes, int n_in, void* d_out, int out_size, void* d_ws, size_t ws_size, hipStream_t stream) {
    static int grid = 0;
    if (grid == 0) {
        if (n_in != 23 || ws_size < WS_END || out_size != TLAT * DM) { fprintf(stderr, "kernel_launch: unexpected problem (n_in %d, ws %zu, out %d)\n", n_in, ws_size, out_size); grid = -1; return; }
        int dev = 0, cus = 0, per_cu = 0;
        hipGetDevice(&dev);
        hipDeviceGetAttribute(&cus, hipDeviceAttributeMultiprocessorCount, dev);
        hipFuncSetAttribute((const void*)fwd_kernel, hipFuncAttributeMaxDynamicSharedMemorySize, LDS_BYTES);
        hipOccupancyMaxActiveBlocksPerMultiprocessor(&per_cu, (const void*)fwd_kernel, NTHREADS, LDS_BYTES);
        if (per_cu < 1) { fprintf(stderr, "kernel_launch: occupancy query says %d blocks per CU\n", per_cu); grid = -1; return; }
        if (per_cu > 2) per_cu = 2;
        grid = cus * per_cu;
        fprintf(stderr, "kernel_launch: grid %d (%d per CU), ws %zu\n", grid, per_cu, ws_size);
    }
    if (grid < 0) return;
    Params p{};
    for (int i = 0; i < 23; ++i) p.in[i] = (const float*)d_in[i];
    p.out = (float*)d_out; p.ws = (unsigned char*)d_ws;
    if (hipMemsetAsync(d_ws, 0, CTL_ZERO_BYTES, stream) != hipSuccess) { fprintf(stderr, "kernel_launch: memset of control words failed\n"); return; }
    int lo = 0, hi = 1000;
    void* args[] = {&p, &lo, &hi};
    hipError_t e = hipLaunchCooperativeKernel((const void*)fwd_kernel, dim3(grid), dim3(NTHREADS), args, LDS_BYTES, stream);
    if (e != hipSuccess) fprintf(stderr, "cooperative launch failed: %s (grid %d)\n", hipGetErrorString(e), grid);
}
```

```cpp
#include <hip/hip_runtime.h>
#include <hip/hip_cooperative_groups.h>
#include <cstdio>
#include <cstdint>
namespace cg = cooperative_groups;

#define DEVINL __device__ __forceinline__
typedef unsigned short bf16_t;
typedef short bf16x8 __attribute__((ext_vector_type(8)));
typedef float f32x4 __attribute__((ext_vector_type(4)));
typedef unsigned u32x4 __attribute__((ext_vector_type(4)));
typedef unsigned u32x2 __attribute__((ext_vector_type(2)));

constexpr int NB = 4, SEQ = 8192, DM = 1024, CTX = 256;
constexpr int TLAT = NB * SEQ;
constexpr int TCTX = NB * CTX;
constexpr int TALL = TLAT + TCTX;
constexpr int KVR = SEQ + CTX;
constexpr int NTHREADS = 512, NWAVES = 8;
constexpr float EPS = 1e-6f;
constexpr float LOG2E = 1.4426950408889634f;
constexpr float QSCALE = 0.125f * LOG2E;
constexpr int ATTN_IN = 1536, GLA_IN = 3104, GLA_IN_PAD = 3328;
constexpr int LDS_BYTES = 144 * 1024;

constexpr size_t MiB = 1u << 20;
constexpr size_t WS_MOD = 1 * MiB;
constexpr size_t WS_WT_ATTN_IN = 2 * MiB;
constexpr size_t WS_WT_ATTN_OUT = 5 * MiB;
constexpr size_t WS_WT_GLA_IN = 7 * MiB;
constexpr size_t WS_WT_GLA_OUT = 14 * MiB;
constexpr size_t WS_WT_PQ0 = 16 * MiB;
constexpr size_t WS_WT_PQ1 = 20 * MiB;
constexpr size_t WS_KEYS = 24 * MiB;
constexpr size_t WS_DEND = 25 * MiB;
constexpr size_t WS_G = 28 * MiB;
constexpr size_t WS_XR = 34 * MiB;
constexpr size_t WS_R1 = 166 * MiB;
constexpr size_t WS_R2 = 232 * MiB;
constexpr size_t WS_R3 = 298 * MiB;
constexpr size_t WS_R4 = 364 * MiB;
constexpr size_t WS_END = 496 * MiB;
constexpr size_t SZ_HALF_R = 33 * MiB;

struct Params {
    const float* in[23];
    float* out;
    unsigned char* ws;
};

DEVINL float bf2f(unsigned v) { return __uint_as_float(v << 16); }
DEVINL unsigned f2bf(float f) { unsigned u = __float_as_uint(f); return (u + 0x7fffu + ((u >> 16) & 1u)) >> 16; }
typedef float f32x2_pk __attribute__((ext_vector_type(2))); typedef __bf16 bf16x2_pk __attribute__((ext_vector_type(2)));
DEVINL unsigned pk2(float lo, float hi) { f32x2_pk v = {lo, hi}; bf16x2_pk b = __builtin_convertvector(v, bf16x2_pk); return __builtin_bit_cast(unsigned, b); }
DEVINL float wave_sum(float v) {
#pragma unroll
    for (int o = 1; o < 64; o <<= 1) v += __shfl_xor(v, o);
    return v;
}
DEVINL float fexp(float x) { return __builtin_amdgcn_exp2f(x * 1.4426950408889634f); }
DEVINL float flog(float x) { return __builtin_amdgcn_logf(x) * 0.6931471805599453f; }
DEVINL float silu_f(float x) { return x * __builtin_amdgcn_rcpf(1.f + fexp(-x)); }
DEVINL float gelu_f(float x) { return 0.5f * x * (1.f + erff(x * 0.70710678118654752f)); }
DEVINL void unpack8(const u32x4 v, float* f) {
    f[0] = __uint_as_float(v.x << 16); f[1] = __uint_as_float(v.x & 0xffff0000u);
    f[2] = __uint_as_float(v.y << 16); f[3] = __uint_as_float(v.y & 0xffff0000u);
    f[4] = __uint_as_float(v.z << 16); f[5] = __uint_as_float(v.z & 0xffff0000u);
    f[6] = __uint_as_float(v.w << 16); f[7] = __uint_as_float(v.w & 0xffff0000u);
}
DEVINL int row_bb(int r) { return r < TLAT ? (r >> 13) : 4; }
DEVINL const float* mod_ptr(const Params& p, int l, int bb, int which) { return (const float*)(p.ws + WS_MOD) + ((size_t)((l * 5 + bb) * 6 + which)) * 1024; }

constexpr float W8_SCALE = 256.f;
template <bool F8W = false>
DEVINL void transpose_item(const float* W, int K, int N, int Npad, bf16_t* WT, int item, float* tile  ) {
    const int nt = Npad / 64, it0 = 2 * item, kb = it0 / nt, nb = it0 % nt, k0 = kb * 64, n0 = nb * 64, tid = threadIdx.x;
    {
        const int nn = tid & 127, kq = tid >> 7, n = n0 + nn;
        float* tl = tile + (nn >> 6) * (64 * 65) + (nn & 63);
#pragma unroll
        for (int i = 0; i < 16; ++i) { const int kk = kq + 4 * i; tl[kk * 65] = (n < N) ? W[(size_t)(k0 + kk) * N + n] : 0.f; }
    }
    __syncthreads();
#pragma unroll
    for (int t = 0; t < 2; ++t) {
        const int c = tid & 7, nn = tid >> 3;
        const float* s = tile + t * (64 * 65) + (8 * c) * 65 + nn;
        if constexpr (F8W) {
#define T8C(i_) fminf(fmaxf(s[(i_) * 65] * W8_SCALE, -448.f), 448.f)
            int w0 = 0, w1 = 0;
            w0 = __builtin_amdgcn_cvt_pk_fp8_f32(T8C(0), T8C(1), w0, false); w0 = __builtin_amdgcn_cvt_pk_fp8_f32(T8C(2), T8C(3), w0, true);
            w1 = __builtin_amdgcn_cvt_pk_fp8_f32(T8C(4), T8C(5), w1, false); w1 = __builtin_amdgcn_cvt_pk_fp8_f32(T8C(6), T8C(7), w1, true);
#undef T8C
            u32x2 o; o.x = (unsigned)w0; o.y = (unsigned)w1;
            *(u32x2*)((unsigned char*)WT + (size_t)(n0 + t * 64 + nn) * K + k0 + 8 * c) = o;
        } else {
        u32x4 o; o.x = pk2(s[0], s[65]); o.y = pk2(s[2 * 65], s[3 * 65]); o.z = pk2(s[4 * 65], s[5 * 65]); o.w = pk2(s[6 * 65], s[7 * 65]);
        *(u32x4*)(WT + (size_t)(n0 + t * 64 + nn) * K + k0 + 8 * c) = o;
        }
    }
    __syncthreads();
}
DEVINL void keyfold_item(const float* Wq  , const float* keys  , unsigned char* WT  , int item, char* smem) {
    constexpr int LS = 132;
    float* sW = (float*)smem;
    float* sK = sW + 64 * LS;
    const int tid = threadIdx.x, hp = item >> 4, k0 = (item & 15) * 64;
    __syncthreads();
#pragma unroll
    for (int i = 0; i < 4; ++i) { const int c = tid + i * NTHREADS, r = c >> 5, q4 = c & 31; *(f32x4*)(sW + r * LS + q4 * 4) = *(const f32x4*)(Wq + (size_t)(k0 + r) * 2048 + hp * 128 + q4 * 4); }
#pragma unroll
    for (int i = 0; i < 8; ++i) { const int c = tid + i * NTHREADS, r = c >> 5, q4 = c & 31; *(f32x4*)(sK + r * LS + q4 * 4) = *(const f32x4*)(keys + (size_t)hp * 16384 + r * 128 + q4 * 4); }
    __syncthreads();
    const int lane = tid & 63, w = tid >> 6, l15 = lane & 15, lq = lane >> 4;
    bf16x8 bk[4];
#pragma unroll
    for (int st = 0; st < 4; ++st) { const float* q = sK + (w * 16 + l15) * LS + st * 32 + lq * 8; const f32x4 x0 = *(const f32x4*)q, x1 = *(const f32x4*)(q + 4);
        const u32x4 pk = (u32x4){pk2(x0.x, x0.y), pk2(x0.z, x0.w), pk2(x1.x, x1.y), pk2(x1.z, x1.w)}; bk[st] = __builtin_bit_cast(bf16x8, pk); }
#pragma unroll
    for (int kt = 0; kt < 4; ++kt) {
        f32x4 acc = (f32x4){0.f, 0.f, 0.f, 0.f};
#pragma unroll
        for (int st = 0; st < 4; ++st) { const float* q = sW + (kt * 16 + l15) * LS + st * 32 + lq * 8; const f32x4 x0 = *(const f32x4*)q, x1 = *(const f32x4*)(q + 4);
            const u32x4 pk = (u32x4){pk2(x0.x, x0.y), pk2(x0.z, x0.w), pk2(x1.x, x1.y), pk2(x1.z, x1.w)};
            acc = __builtin_amdgcn_mfma_f32_16x16x32_bf16(__builtin_bit_cast(bf16x8, pk), bk[st], acc, 0, 0, 0); }
        int w8 = 0;
        w8 = __builtin_amdgcn_cvt_pk_fp8_f32(fminf(fmaxf(acc[0] * W8_SCALE, -448.f), 448.f), fminf(fmaxf(acc[1] * W8_SCALE, -448.f), 448.f), w8, false);
        w8 = __builtin_amdgcn_cvt_pk_fp8_f32(fminf(fmaxf(acc[2] * W8_SCALE, -448.f), 448.f), fminf(fmaxf(acc[3] * W8_SCALE, -448.f), 448.f), w8, true);
        *(int*)(WT + (size_t)(hp * 128 + w * 16 + l15) * 1024 + k0 + kt * 16 + 4 * lq) = w8;
    }
}
DEVINL void phase_prologue(const Params& p, char* smem) {
    const int tid = threadIdx.x, lane = tid & 63, wid = tid >> 6;
    constexpr int I_MOD = 96;
    constexpr int I_T0 = 8 * 24, I_T1 = 8 * 16, I_T2 = 8 * 52, I_T3 = 8 * 16, I_T4 = 256, I_T5 = 256;
    constexpr int I_KEYS = 0;
    constexpr int NITEMS = I_MOD + I_T0 + I_T1 + I_T2 + I_T3 + I_T4 + I_T5 + I_KEYS;
    float* sS = (float*)(smem + 36864);
    if (blockIdx.x < I_MOD) {
        for (int i = tid; i < 5 * 1024; i += NTHREADS) sS[i] = silu_f(i < 4096 ? p.in[1][i] : p.in[3][i - 4096]);
        __syncthreads();
    }
    for (int it = blockIdx.x; it < NITEMS; it += gridDim.x) {
        int r = it;
        if (r < I_MOD) {
            const int wt = r * 8 + wid, l = wt / 384, n0 = (wt % 384) * 16, kq = lane >> 4, nn = lane & 15;
            const float* W = p.in[4] + (size_t)l * 1024 * 6144 + n0 + nn;
            float a0 = 0.f, a1 = 0.f, a2 = 0.f, a3 = 0.f, a4 = 0.f;
#pragma unroll 16
            for (int i = 0; i < 256; ++i) {
                const int k = kq + 4 * i;
                const float w = W[(size_t)k * 6144];
                a0 += sS[k] * w; a1 += sS[1024 + k] * w; a2 += sS[2048 + k] * w; a3 += sS[3072 + k] * w; a4 += sS[4096 + k] * w;
            }
            a0 += __shfl_xor(a0, 16); a0 += __shfl_xor(a0, 32); a1 += __shfl_xor(a1, 16); a1 += __shfl_xor(a1, 32); a2 += __shfl_xor(a2, 16); a2 += __shfl_xor(a2, 32);
            a3 += __shfl_xor(a3, 16); a3 += __shfl_xor(a3, 32); a4 += __shfl_xor(a4, 16); a4 += __shfl_xor(a4, 32);
            if (kq == 0) {
                const float bias = p.in[5][l * 6144 + n0 + nn];
                float* M = (float*)(p.ws + WS_MOD) + (size_t)l * 5 * 6144 + n0 + nn;
                M[0] = a0 + bias; M[6144] = a1 + bias; M[2 * 6144] = a2 + bias; M[3 * 6144] = a3 + bias; M[4 * 6144] = a4 + bias;
            }
            continue;
        }
        r -= I_MOD;
        float* tile = (float*)smem;
        if (r < I_T0) { transpose_item<true>(p.in[8], 1024, 1536, 1536, (bf16_t*)(p.ws + WS_WT_ATTN_IN), r, tile); continue; } r -= I_T0;
        if (r < I_T1) { transpose_item<true>(p.in[12], 1024, 1024, 1024, (bf16_t*)(p.ws + WS_WT_ATTN_OUT), r, tile); continue; } r -= I_T1;
        if (r < I_T2) { transpose_item<true>(p.in[13], 1024, GLA_IN, GLA_IN_PAD, (bf16_t*)(p.ws + WS_WT_GLA_IN), r, tile); continue; } r -= I_T2;
        if (r < I_T3) { transpose_item<true>(p.in[17], 1024, 1024, 1024, (bf16_t*)(p.ws + WS_WT_GLA_OUT), r, tile); continue; } r -= I_T3;
        if (r < I_T4) { keyfold_item(p.in[18], p.in[19], p.ws + WS_WT_PQ0, r, smem); __syncthreads(); continue; } r -= I_T4;
        if (r < I_T5) { keyfold_item(p.in[18] + (size_t)1024 * 2048, p.in[19] + (size_t)16 * 16384, p.ws + WS_WT_PQ1, r, smem); __syncthreads(); continue; } r -= I_T5;
        {
            const size_t e0 = ((size_t)r * 512 + tid) * 8;
            const f32x4 a = *(const f32x4*)(p.in[19] + e0), b = *(const f32x4*)(p.in[19] + e0 + 4);
            u32x4 o; o.x = pk2(a.x, a.y); o.y = pk2(a.z, a.w); o.z = pk2(b.x, b.y); o.w = pk2(b.z, b.w);
            *(u32x4*)((bf16_t*)(p.ws + WS_KEYS) + e0) = o;
        }
    }
}

constexpr float F8_SCALE = 32.f, O8_SCALE = 32.f, Y8_SCALE = 16.f;
template <bool SRC16 = false>
DEVINL void phase_norm_mod(const Params& p, const void* src_lat, const void* src_ctx, int nrows, const float* gain, int layer, int w_sh, int w_sc, bf16_t* dst, unsigned char* dst8 = nullptr) {
    const int lane = threadIdx.x & 63, gw = blockIdx.x * NWAVES + (threadIdx.x >> 6), ngw = gridDim.x * NWAVES;
    constexpr int ESZ = SRC16 ? 2 : 4;
#define NM_ROWPTR(r_) ((const char*)((r_) < TLAT ? src_lat : src_ctx) + (size_t)((r_) < TLAT ? (r_) : (r_) - TLAT) * DM * ESZ)
#define NM_LOAD(dst_, rp_, j_) do { if constexpr (SRC16) { const u32x2 t_ = *(const u32x2*)((rp_) + (size_t)((j_) * 64 + lane) * 4 * ESZ); dst_ = (u32x4){t_.x, t_.y, 0u, 0u}; } else dst_ = *(const u32x4*)((rp_) + (size_t)((j_) * 64 + lane) * 4 * ESZ); } while (0)
#define NM_CVT(raw_) (SRC16 ? (f32x4){__uint_as_float((raw_).x << 16), __uint_as_float((raw_).x & 0xffff0000u), __uint_as_float((raw_).y << 16), __uint_as_float((raw_).y & 0xffff0000u)} \
                            : (f32x4){__uint_as_float((raw_).x), __uint_as_float((raw_).y), __uint_as_float((raw_).z), __uint_as_float((raw_).w)})
    u32x4 nvA[4], nvB[4];
    if (gw < nrows) { const char* rp = NM_ROWPTR(gw);
#pragma unroll
        for (int j = 0; j < 4; ++j) NM_LOAD(nvA[j], rp, j);
    }
    if (gw + ngw < nrows) { const char* rp = NM_ROWPTR(gw + ngw);
#pragma unroll
        for (int j = 0; j < 4; ++j) NM_LOAD(nvB[j], rp, j);
    }
    f32x4 wv[4], sv[4]; int cur_bb = -1;
#define NM_PROCESS(row_, nv_, nrow_) do { \
        const int bb = row_bb(row_); \
        if (bb != cur_bb) { cur_bb = bb; const float* sh = mod_ptr(p, layer, bb, w_sh); const float* sc = mod_ptr(p, layer, bb, w_sc); \
            _Pragma("unroll") for (int j = 0; j < 4; ++j) { const int c = (j * 64 + lane) * 4; wv[j] = *(const f32x4*)(gain + c) * (*(const f32x4*)(sc + c) + 1.f); sv[j] = *(const f32x4*)(sh + c); } } \
        f32x4 v[4]; float ss = 0.f; \
        _Pragma("unroll") for (int j = 0; j < 4; ++j) { v[j] = NM_CVT(nv_[j]); ss += (v[j].x * v[j].x + v[j].y * v[j].y) + (v[j].z * v[j].z + v[j].w * v[j].w); } \
        if ((nrow_) < nrows) { const char* rp = NM_ROWPTR(nrow_); _Pragma("unroll") for (int j = 0; j < 4; ++j) NM_LOAD(nv_[j], rp, j); } \
        const float rinv = rsqrtf(wave_sum(ss) * (1.f / DM) + EPS); \
        _Pragma("unroll") for (int j = 0; j < 4; ++j) { \
            const int c = (j * 64 + lane) * 4; \
            const f32x4 y = v[j] * rinv * wv[j] + sv[j]; \
            if (dst) { u32x2 o; o.x = pk2(y.x, y.y); o.y = pk2(y.z, y.w); *(u32x2*)(dst + (size_t)(row_) * DM + c) = o; } \
            if (dst8) {       \
                int w8 = 0; w8 = __builtin_amdgcn_cvt_pk_fp8_f32(fminf(fmaxf(y.x * F8_SCALE, -448.f), 448.f), fminf(fmaxf(y.y * F8_SCALE, -448.f), 448.f), w8, false); \
                w8 = __builtin_amdgcn_cvt_pk_fp8_f32(fminf(fmaxf(y.z * F8_SCALE, -448.f), 448.f), fminf(fmaxf(y.w * F8_SCALE, -448.f), 448.f), w8, true); \
                *(int*)(dst8 + (size_t)(row_) * DM + c) = w8; } } \
    } while (0)
    for (int row = gw; row < nrows; row += 2 * ngw) {
        NM_PROCESS(row, nvA, row + 2 * ngw);
        if (row + ngw < nrows) NM_PROCESS(row + ngw, nvB, row + 3 * ngw);
    }
#undef NM_PROCESS
}
#undef NM_ROWPTR
#undef NM_LOAD
#undef NM_CVT

namespace pg8 {
#define PG8_LAS __attribute__((address_space(3)))
typedef unsigned short bf16_t;
typedef short bf16x8 __attribute__((ext_vector_type(8)));
typedef float f32x4 __attribute__((ext_vector_type(4)));
typedef unsigned u32x4 __attribute__((ext_vector_type(4)));
constexpr int BM = 256, BK = 64, HALF = 128, HTB = HALF * BK * 2  , STAGE_BYTES = 8 * HTB, NXCD = 8, WGM = 8;

__host__ __device__ __forceinline__ int lds_byte(int r, int c) { const int st = (r >> 4) * 2 + (c >> 5), rr = r & 15, cc = c & 31, ob = rr * 64 + cc * 2; return st * 1024 + (ob ^ (((ob >> 9) & 1) << 5)); }
__host__ __device__ __forceinline__ void stage_rc(int b, int& R, int& C) { const int st = b / 1024, sb = b % 1024, swz = sb ^ (((sb >> 9) & 1) << 5); R = (st >> 1) * 16 + swz / 64; C = (st & 1) * 32 + (swz % 64) / 2; }
__host__ __device__ __forceinline__ int perm32(int rho) { const int n = rho >> 4, i = rho & 15; return 8 * (i >> 2) + 4 * n + (i & 3); }

struct Unit { int pm, pn; };
struct Gemm { const bf16_t* A; const bf16_t* Bt; int M, N, K; };

struct StaticOrder {
    int nM, nN, nwg, G, c;
    __host__ __device__ void init(int M, int N, int G_, int c_) { nM = M / BM; nN = N / BM; nwg = nM * nN; G = G_; c = c_; }
    __host__ __device__ bool next(int i, Unit& u) const {
        const long L = (long)i * G + c; if (L >= nwg) return false;
        int wgid = (int)L; { const int q = nwg / NXCD, r = nwg % NXCD, xcd = wgid % NXCD, off = wgid / NXCD; wgid = (xcd < r ? xcd * (q + 1) : r * (q + 1) + (xcd - r) * q) + off; }
        const int nig = WGM * nN, gid = wgid / nig, fm = gid * WGM, gsz = (nM - fm) < WGM ? (nM - fm) : WGM;
        u.pm = fm + ((wgid % nig) % gsz); u.pn = (wgid % nig) / gsz; return true;
    }
    __device__ __forceinline__ void a_ready(const Unit&) const {}
    __device__ __forceinline__ void done(const Unit&) const {}
};

typedef int i32x4v __attribute__((ext_vector_type(4)));
typedef int i32x8v __attribute__((ext_vector_type(8)));
__device__ __forceinline__ i32x8v cat8(bf16x8 a, bf16x8 b) { return __builtin_shufflevector((i32x4v)a, (i32x4v)b, 0, 1, 2, 3, 4, 5, 6, 7); }
__device__ __forceinline__ unsigned cvt_pk_bf16(float lo, float hi) { unsigned r; asm volatile("v_cvt_pk_bf16_f32 %0, %1, %2" : "=v"(r) : "v"(lo), "v"(hi)); return r; }

struct EpiStoreBf16 {
    static constexpr bool PERM = true, AFTER_DRAIN = false;
    bf16_t* O; int ldc; float sc;
    __device__ __forceinline__ void operator()(const f32x4 (&acc)[2][2][4][2], const Unit& u, int wr, int wc, int fr, int fq) const {
        const int row0 = u.pm * BM + wr * 64 + fr, col0 = u.pn * BM + wc * 32 + 8 * fq;
#pragma unroll
        for (int ai = 0; ai < 2; ++ai)
#pragma unroll
            for (int m = 0; m < 4; ++m) { bf16_t* rowp = O + (size_t)(row0 + ai * HALF + m * 16) * ldc + col0;
#pragma unroll
                for (int bj = 0; bj < 2; ++bj) { const f32x4 v0 = acc[ai][bj][m][0] * sc, v1 = acc[ai][bj][m][1] * sc;
                    u32x4 w; w.x = cvt_pk_bf16(v0[0], v0[1]); w.y = cvt_pk_bf16(v0[2], v0[3]); w.z = cvt_pk_bf16(v1[0], v1[1]); w.w = cvt_pk_bf16(v1[2], v1[3]);
                    *(u32x4*)(rowp + bj * HALF) = w; } }
    }
};
struct EpiStoreKeys {
    static constexpr bool PERM = true, AFTER_DRAIN = false;
    bf16_t* O; int ldc; float sc;
    static __device__ __forceinline__ unsigned keyed(unsigned w) { return w ^ (((w >> 15) & 0x00010001u) * 0x7fffu); }
    __device__ __forceinline__ void operator()(const f32x4 (&acc)[2][2][4][2], const Unit& u, int wr, int wc, int fr, int fq) const {
#pragma unroll
        for (int ai = 0; ai < 2; ++ai)
#pragma unroll
            for (int m = 0; m < 4; ++m) { const int rb = (u.pm * BM + ai * HALF + wr * 64 + m * 16) >> 4;
#pragma unroll
                for (int bj = 0; bj < 2; ++bj) { const f32x4 v0 = acc[ai][bj][m][0] * sc, v1 = acc[ai][bj][m][1] * sc;
                    u32x4 w; w.x = keyed(cvt_pk_bf16(v0[0], v0[1])); w.y = keyed(cvt_pk_bf16(v0[2], v0[3])); w.z = keyed(cvt_pk_bf16(v1[0], v1[1])); w.w = keyed(cvt_pk_bf16(v1[2], v1[3]));
                    *(u32x4*)(O + (((((size_t)rb * 16 + (u.pn * 2 + bj)) * 16 + (wc * 4 + fq)) * 16 + fr) << 3)) = w; } }
    }
};
template <bool IN16>
struct EpiResid {
    static constexpr bool PERM = true, AFTER_DRAIN = false;
    const void* xin_lat; const void* xin_ctx; bf16_t* XR; const float* gate_base; float sc;
    __device__ __forceinline__ void operator()(const f32x4 (&acc)[2][2][4][2], const Unit& u, int wr, int wc, int fr, int fq) const {
        const int row0 = u.pm * BM + wr * 64 + fr, col0 = u.pn * BM + wc * 32 + 8 * fq;
#pragma unroll
        for (int ai = 0; ai < 2; ++ai)
#pragma unroll
            for (int m = 0; m < 4; ++m) { const int row = row0 + ai * HALF + m * 16;
                const size_t xoff = row < TLAT ? (size_t)row * 1024 : (size_t)(row - TLAT) * 1024; const void* xb = row < TLAT ? xin_lat : xin_ctx;
                const float* gb = gate_base + (size_t)row_bb(row) * 6144; bf16_t* xo = XR + (size_t)row * 1024;
#pragma unroll
                for (int bj = 0; bj < 2; ++bj) { const int c = col0 + bj * HALF;
                    f32x4 x0, x1;
                    if constexpr (IN16) { const u32x4 r = *(const u32x4*)((const bf16_t*)xb + xoff + c);
                        x0 = (f32x4){__uint_as_float(r.x << 16), __uint_as_float(r.x & 0xffff0000u), __uint_as_float(r.y << 16), __uint_as_float(r.y & 0xffff0000u)};
                        x1 = (f32x4){__uint_as_float(r.z << 16), __uint_as_float(r.z & 0xffff0000u), __uint_as_float(r.w << 16), __uint_as_float(r.w & 0xffff0000u)};
                    } else { x0 = *(const f32x4*)((const float*)xb + xoff + c); x1 = *(const f32x4*)((const float*)xb + xoff + c + 4); }
                    const f32x4 v0 = x0 + *(const f32x4*)(gb + c) * (acc[ai][bj][m][0] * sc), v1 = x1 + *(const f32x4*)(gb + c + 4) * (acc[ai][bj][m][1] * sc);
                    u32x4 w; w.x = cvt_pk_bf16(v0[0], v0[1]); w.y = cvt_pk_bf16(v0[2], v0[3]); w.z = cvt_pk_bf16(v1[0], v1[1]); w.w = cvt_pk_bf16(v1[2], v1[3]);
                    *(u32x4*)(xo + c) = w; } }
    }
};
struct EpiGla {
    static constexpr bool PERM = true, AFTER_DRAIN = false;
    bf16_t* QK; bf16_t* VR; float* G; float sc;
    __device__ __forceinline__ void operator()(const f32x4 (&acc)[2][2][4][2], const Unit& u, int wr, int wc, int fr, int fq) const {
        const int row0 = u.pm * BM + wr * 64 + fr, colt = u.pn * BM;
        if (colt < 3072) {
            bf16_t* base = colt < 1024 ? QK : VR; const int ldc = colt < 1024 ? 1024 : 2048, col0 = (colt < 1024 ? colt : colt - 1024) + wc * 32 + 8 * fq;
#pragma unroll
            for (int ai = 0; ai < 2; ++ai)
#pragma unroll
                for (int m = 0; m < 4; ++m) { bf16_t* rowp = base + (size_t)(row0 + ai * HALF + m * 16) * ldc + col0;
#pragma unroll
                    for (int bj = 0; bj < 2; ++bj) { const f32x4 v0 = acc[ai][bj][m][0] * sc, v1 = acc[ai][bj][m][1] * sc;
                        u32x4 w; w.x = cvt_pk_bf16(v0[0], v0[1]); w.y = cvt_pk_bf16(v0[2], v0[3]); w.z = cvt_pk_bf16(v1[0], v1[1]); w.w = cvt_pk_bf16(v1[2], v1[3]);
                        *(u32x4*)(rowp + bj * HALF) = w; } }
        } else if (wc == 0) {
#pragma unroll
            for (int ai = 0; ai < 2; ++ai)
#pragma unroll
                for (int m = 0; m < 4; ++m) { float* gp = G + (size_t)(row0 + ai * HALF + m * 16) * 32 + 8 * fq;
                    *(f32x4*)gp = acc[ai][0][m][0] * sc; *(f32x4*)(gp + 4) = acc[ai][0][m][1] * sc; }
        }
    }
};

template <class Epi, class Sched, bool ALIGN_EPI = false, bool SP2 = false, bool F8 = false>
__device__ __forceinline__ void gemm_phase(PG8_LAS unsigned char* lds, const Gemm g, const Sched& S, const Epi& E) {
    const int tid = threadIdx.x, wid = __builtin_amdgcn_readfirstlane(tid >> 6), lane = tid & 63, wr = wid >> 2, wc = wid & 3, fr = lane & 15, fq = lane >> 4;
    const int K = g.K, nt = K / BK;
    unsigned voffA[2], voffB[2];
#pragma unroll
    for (int i = 0; i < 2; ++i) { int R, C; stage_rc(tid * 16 + i * 8192, R, C); const int Rb = Epi::PERM ? ((R & ~31) + perm32(R & 31)) : R;
        voffA[i] = (unsigned)(R * K + C) * 2u; voffB[i] = (unsigned)(Rb * K + C) * 2u; }
    const size_t kstep = (size_t)(BK * 2);
    const size_t hstep = (size_t)HALF * K * 2;
    const size_t tstep = 2 * hstep;
    const unsigned ldsw = (unsigned)wid * 1024u;
    const int aoff = lds_byte(wr * 64 + fr, fq * 8), boff = lds_byte(wc * 32 + fr, fq * 8);
#define PG8_SA(b, h) (((b) * 2 + (h)) * HTB)
#define PG8_SB(b, h) ((4 + (b) * 2 + (h)) * HTB)
#define PG8_STAGE(bufoff, gbase, voff) do { _Pragma("unroll") for (int _i = 0; _i < 2; ++_i) \
        __builtin_amdgcn_global_load_lds((const unsigned*)((const char*)(gbase) + (voff)[_i]), (PG8_LAS unsigned*)(lds + (bufoff) + ldsw + _i * 8192), 16, 0, 0); } while (0)
#define PG8_LDA(dst, b, h) do { _Pragma("unroll") for (int m = 0; m < 4; ++m) { if constexpr (F8) dst##8[m] = cat8(*(const PG8_LAS bf16x8*)(lds + PG8_SA(b, h) + aoff + m * 2048), *(const PG8_LAS bf16x8*)(lds + PG8_SA(b, h) + aoff + m * 2048 + 1024)); \
        else { _Pragma("unroll") for (int k = 0; k < 2; ++k) dst[m][k] = *(const PG8_LAS bf16x8*)(lds + PG8_SA(b, h) + aoff + m * 2048 + k * 1024); } } } while (0)
#define PG8_LDB(dst, b, h) do { _Pragma("unroll") for (int n = 0; n < 2; ++n) { if constexpr (F8) dst##8[n] = cat8(*(const PG8_LAS bf16x8*)(lds + PG8_SB(b, h) + boff + n * 2048), *(const PG8_LAS bf16x8*)(lds + PG8_SB(b, h) + boff + n * 2048 + 1024)); \
        else { _Pragma("unroll") for (int k = 0; k < 2; ++k) dst[n][k] = *(const PG8_LAS bf16x8*)(lds + PG8_SB(b, h) + boff + n * 2048 + k * 1024); } } } while (0)
#define PG8_MMA(ai, bj, At, Bt) do { __builtin_amdgcn_s_setprio(1); _Pragma("unroll") for (int m = 0; m < 4; ++m) _Pragma("unroll") for (int n = 0; n < 2; ++n) { \
        if constexpr (F8) asm volatile("v_mfma_f32_16x16x128_f8f6f4 %0, %1, %2, %0" : "+v"(acc[ai][bj][m][n]) : "v"(Bt##8[n]), "v"(At##8[m]));   \
        else { _Pragma("unroll") for (int k = 0; k < 2; ++k) acc[ai][bj][m][n] = __builtin_amdgcn_mfma_f32_16x16x32_bf16(Bt[n][k], At[m][k], acc[ai][bj][m][n], 0, 0, 0); } } __builtin_amdgcn_s_setprio(0); } while (0)
#define PG8_WAIT_V(n) asm volatile("s_waitcnt vmcnt(" #n ")" ::: "memory")
#define PG8_WAIT_L(n) asm volatile("s_waitcnt lgkmcnt(" #n ")" ::: "memory")
#define PG8_BAR __builtin_amdgcn_s_barrier()
#define PG8_SCHED __builtin_amdgcn_sched_barrier(0)
    Unit cur, nxt; int ui = 0;
    if (!S.next(0, cur)) return;
    f32x4 acc[2][2][4][2];
#pragma unroll
    for (int a = 0; a < 2; ++a)
#pragma unroll
        for (int b = 0; b < 2; ++b)
#pragma unroll
            for (int m = 0; m < 4; ++m)
#pragma unroll
                for (int n = 0; n < 2; ++n) acc[a][b][m][n] = (f32x4){0.f, 0.f, 0.f, 0.f};
    bf16x8 At[4][2], B0[2][2], B1[2][2];
    i32x8v At8[4], B08[2], B18[2];
    const char* cA = (const char*)g.A + (size_t)cur.pm * tstep; const char* cB = (const char*)g.Bt + (size_t)cur.pn * tstep;
    S.a_ready(cur);
    if constexpr (SP2) {
        PG8_STAGE(PG8_SB(0, 0), cB, voffB); PG8_STAGE(PG8_SB(0, 1), cB + hstep, voffB); PG8_STAGE(PG8_SA(0, 0), cA, voffA); PG8_STAGE(PG8_SA(0, 1), cA + hstep, voffA);
        if (wr == 1) PG8_BAR;
        PG8_WAIT_V(2); PG8_BAR;
        PG8_STAGE(PG8_SB(1, 0), cB + kstep, voffB); PG8_STAGE(PG8_SA(1, 0), cA + kstep, voffA); PG8_STAGE(PG8_SB(1, 1), cB + hstep + kstep, voffB);
        PG8_WAIT_V(6); PG8_BAR;
    } else {
        PG8_STAGE(PG8_SB(0, 0), cB, voffB); PG8_STAGE(PG8_SA(0, 0), cA, voffA); PG8_STAGE(PG8_SB(0, 1), cB + hstep, voffB); PG8_STAGE(PG8_SA(0, 1), cA + hstep, voffA);
        if (wr == 1) PG8_BAR;
        PG8_WAIT_V(4); PG8_BAR;
        PG8_STAGE(PG8_SB(1, 0), cB + kstep, voffB); PG8_STAGE(PG8_SA(1, 0), cA + kstep, voffA); PG8_STAGE(PG8_SB(1, 1), cB + hstep + kstep, voffB);
        PG8_WAIT_V(6); PG8_BAR;
    }
    for (;;) {
        const bool has_next = S.next(ui + 1, nxt);
        const char* nA = has_next ? (const char*)g.A + (size_t)nxt.pm * tstep : cA; const char* nB = has_next ? (const char*)g.Bt + (size_t)nxt.pn * tstep : cB;
#pragma unroll 1
        for (int t = 0; t < nt; t += 2) {
            const bool last = (t == nt - 2);
            const char* a1 = cA + (size_t)(t + 1) * kstep;
            const char* a2 = last ? nA : cA + (size_t)(t + 2) * kstep; const char* b2 = last ? nB : cB + (size_t)(t + 2) * kstep;
            const char* a3 = a2 + kstep; const char* b3 = b2 + kstep;
            if (last && has_next) S.a_ready(nxt);
            if constexpr (SP2) {
            PG8_LDB(B0, 0, 0); PG8_LDB(B1, 0, 1); PG8_SCHED; PG8_LDA(At, 0, 0); PG8_STAGE(PG8_SA(1, 1), a1 + hstep, voffA);
            PG8_WAIT_V(8); PG8_WAIT_L(0); PG8_BAR; PG8_MMA(0, 0, At, B0); PG8_MMA(0, 1, At, B1); PG8_BAR; PG8_SCHED;
            PG8_LDA(At, 0, 1); PG8_STAGE(PG8_SB(0, 0), b2, voffB); PG8_STAGE(PG8_SB(0, 1), b2 + hstep, voffB); PG8_STAGE(PG8_SA(0, 0), a2, voffA);
            PG8_WAIT_V(8); PG8_WAIT_L(0); PG8_BAR; PG8_MMA(1, 0, At, B0); PG8_MMA(1, 1, At, B1); PG8_BAR; PG8_SCHED;
            PG8_LDB(B0, 1, 0); PG8_LDB(B1, 1, 1); PG8_SCHED; PG8_LDA(At, 1, 0); PG8_STAGE(PG8_SA(0, 1), a2 + hstep, voffA);
            PG8_WAIT_V(8); PG8_WAIT_L(0); PG8_BAR; PG8_MMA(0, 0, At, B0); PG8_MMA(0, 1, At, B1); PG8_BAR; PG8_SCHED;
            PG8_LDA(At, 1, 1); PG8_STAGE(PG8_SB(1, 0), b3, voffB); PG8_STAGE(PG8_SB(1, 1), b3 + hstep, voffB); PG8_STAGE(PG8_SA(1, 0), a3, voffA);
            PG8_WAIT_V(8); PG8_WAIT_L(0); PG8_BAR; PG8_MMA(1, 0, At, B0); PG8_MMA(1, 1, At, B1); PG8_BAR; PG8_SCHED;
            } else {
            PG8_LDB(B0, 0, 0); PG8_SCHED; PG8_LDA(At, 0, 0); PG8_STAGE(PG8_SA(1, 1), a1 + hstep, voffA);
            PG8_WAIT_L(8); PG8_BAR; PG8_WAIT_L(0); PG8_MMA(0, 0, At, B0); PG8_BAR; PG8_SCHED;
            PG8_LDB(B1, 0, 1); PG8_STAGE(PG8_SB(0, 0), b2, voffB);
            PG8_BAR; PG8_WAIT_L(0); PG8_MMA(0, 1, At, B1); PG8_BAR;
            PG8_LDA(At, 0, 1); PG8_STAGE(PG8_SA(0, 0), a2, voffA);
            PG8_BAR; PG8_WAIT_L(0); PG8_MMA(1, 0, At, B0); PG8_BAR; PG8_SCHED;
            PG8_STAGE(PG8_SB(0, 1), b2 + hstep, voffB);
            PG8_WAIT_V(6); PG8_BAR; PG8_MMA(1, 1, At, B1); PG8_BAR;
            PG8_LDB(B0, 1, 0); PG8_SCHED; PG8_LDA(At, 1, 0); PG8_STAGE(PG8_SA(0, 1), a2 + hstep, voffA);
            PG8_WAIT_L(8); PG8_BAR; PG8_WAIT_L(0); PG8_MMA(0, 0, At, B0); PG8_BAR; PG8_SCHED;
            PG8_LDB(B1, 1, 1); PG8_STAGE(PG8_SB(1, 0), b3, voffB);
            PG8_BAR; PG8_WAIT_L(0); PG8_MMA(0, 1, At, B1); PG8_BAR;
            PG8_LDA(At, 1, 1); PG8_STAGE(PG8_SA(1, 0), a3, voffA);
            PG8_BAR; PG8_WAIT_L(0); PG8_MMA(1, 0, At, B0); PG8_BAR; PG8_SCHED;
            PG8_STAGE(PG8_SB(1, 1), b3 + hstep, voffB);
            PG8_WAIT_V(6); PG8_BAR; PG8_MMA(1, 1, At, B1); PG8_BAR;
            }
        }
        if constexpr (F8) asm volatile("s_nop 15\n\ts_nop 15" ::: "memory");
        if constexpr (ALIGN_EPI) { if (wr == 0) PG8_BAR; }
        if constexpr (!Epi::AFTER_DRAIN) { E(acc, cur, wr, wc, fr, fq); S.done(cur); }
        if (!has_next) break;
#pragma unroll
        for (int a = 0; a < 2; ++a)
#pragma unroll
            for (int b = 0; b < 2; ++b)
#pragma unroll
                for (int m = 0; m < 4; ++m)
#pragma unroll
                    for (int n = 0; n < 2; ++n) acc[a][b][m][n] = (f32x4){0.f, 0.f, 0.f, 0.f};
        cur = nxt; cA = nA; cB = nB; ++ui;
        if constexpr (ALIGN_EPI) { if (wr == 1) PG8_BAR; }
    }
    PG8_WAIT_V(0);
    if constexpr (!ALIGN_EPI) { if (wr == 0) PG8_BAR; }
    PG8_BAR;
    if constexpr (Epi::AFTER_DRAIN) { E.fused(acc, cur, wr, wc, fr, fq, lds, wid, lane); S.done(cur); }
#undef PG8_SA
#undef PG8_SB
#undef PG8_STAGE
#undef PG8_LDA
#undef PG8_LDB
#undef PG8_MMA
#undef PG8_WAIT_V
#undef PG8_WAIT_L
#undef PG8_BAR
#undef PG8_SCHED
}
}

DEVINL void phase_qkpost(const Params& p) {
    const int lane = threadIdx.x & 63, gw = blockIdx.x * NWAVES + (threadIdx.x >> 6), ngw = gridDim.x * NWAVES;
    const bf16_t* P0 = (const bf16_t*)(p.ws + WS_R4);
    bf16_t* Q = (bf16_t*)(p.ws + WS_R2);
    bf16_t* KA = (bf16_t*)(p.ws + WS_R3); bf16_t* VA = KA + (size_t)NB * KVR * 128; bf16_t* KB = VA + (size_t)NB * KVR * 128; bf16_t* VB = KB + (size_t)NB * KVR * 128;
    const int hs = lane >> 3, c8 = lane & 7, d0 = c8 * 8;
    const int ax = c8 >> 2, hf = (c8 >> 1) & 1, p0 = (c8 & 1) * 8;
    float qg[8], kg[8], inv[8];
#pragma unroll
    for (int i = 0; i < 8; ++i) { qg[i] = p.in[10][d0 + i]; kg[i] = p.in[11][d0 + i]; inv[i] = exp2f(-(float)(p0 + i) * (13.287712379549449f / 16.f)) * 0.15915494309189535f; }
    u32x4 rb[4][3];
#pragma unroll
    for (int q = 0; q < 4; ++q) { const int r = gw + q * ngw; if (r < TALL) {
#pragma unroll
        for (int g = 0; g < 3; ++g) rb[q][g] = *(const u32x4*)(P0 + (size_t)r * ATTN_IN + g * 512 + lane * 8); } }
    for (int row4 = gw; row4 < TALL; row4 += 4 * ngw) {
#pragma unroll
      for (int q = 0; q < 4; ++q) {
        const int row = row4 + q * ngw;
        if (row >= TALL) break;
        const bool lat = row < TLAT;
        float cs[8], sn[8]; size_t kvrow;
        if (lat) {
            const int b = row >> 13, t = row & 8191; const float pos = (float)(ax ? (t & 63) : (t >> 6)); kvrow = (size_t)b * KVR + CTX + t;
#pragma unroll
            for (int i = 0; i < 8; ++i) { const float rev = pos * inv[i]; const float fr = rev - floorf(rev); sn[i] = __builtin_amdgcn_sinf(fr); cs[i] = __builtin_amdgcn_cosf(fr); }
        } else {
            const int rc = row - TLAT, b = rc >> 8, j = rc & 255; kvrow = (size_t)b * KVR + j;
#pragma unroll
            for (int i = 0; i < 8; ++i) { sn[i] = 0.f; cs[i] = 1.f; }
        }
        u32x4 raw[3];
#pragma unroll
        for (int g = 0; g < 3; ++g) raw[g] = rb[q][g];
        if (row + 4 * ngw < TALL) {
#pragma unroll
            for (int g = 0; g < 3; ++g) rb[q][g] = *(const u32x4*)(P0 + (size_t)(row + 4 * ngw) * ATTN_IN + g * 512 + lane * 8);
        }
#pragma unroll
        for (int g = 0; g < 3; ++g) {
            const int slot = g * 8 + hs;
            float v[8]; unpack8(raw[g], v);
            const bool isq = (slot < 8) || (slot >= 12 && slot < 20);
            const bool isv = (slot == 10 || slot == 11 || slot >= 22);
            const bool isB = slot >= 12;
            float ss = 0.f;
#pragma unroll
            for (int i = 0; i < 8; ++i) ss += v[i] * v[i];
            ss += __shfl_xor(ss, 1); ss += __shfl_xor(ss, 2); ss += __shfl_xor(ss, 4);
            const float rn = rsqrtf(ss * (1.f / 64.f) + EPS);
            float o[8];
#pragma unroll
            for (int i = 0; i < 8; ++i) {
                float x = v[i];
                if (isB && !isv) x = x * rn * (isq ? qg[i] : kg[i]);
                const float pt = __shfl_xor(x, 2);
                if (!isv) x = hf ? (pt * sn[i] + x * cs[i]) : (x * cs[i] - pt * sn[i]);
                if (isq) x *= QSCALE;
                o[i] = x;
            }
            u32x4 w; w.x = pk2(o[0], o[1]); w.y = pk2(o[2], o[3]); w.z = pk2(o[4], o[5]); w.w = pk2(o[6], o[7]);
            bf16_t* dst;
            if (slot < 8) dst = Q + (size_t)row * 1024 + slot * 64;
            else if (slot < 10) dst = KA + kvrow * 128 + (slot - 8) * 64;
            else if (slot < 12) dst = VA + kvrow * 128 + (slot - 10) * 64;
            else if (slot < 20) dst = Q + (size_t)row * 1024 + 512 + (slot - 12) * 64;
            else if (slot < 22) dst = KB + kvrow * 128 + (slot - 20) * 64;
            else dst = VB + kvrow * 128 + (slot - 22) * 64;
            *(u32x4*)(dst + d0) = w;
        }
      }
    }
}

namespace attn_body {
using bf16=unsigned short;
using bf16x8=__attribute__((ext_vector_type(8)))short;
using s16x4=__attribute__((ext_vector_type(4)))short;
using f32x16=__attribute__((ext_vector_type(16)))float;
using u32x4=__attribute__((ext_vector_type(4)))unsigned;
constexpr int D=64,QP=1024,KP=128;
constexpr int NW=8,QBLK=32,QB=QBLK*NW,KVBLK=64;
__device__ __forceinline__ int crow(int r,int hi){return (r&3)+8*(r>>2)+4*hi;}
__device__ __forceinline__ unsigned f2bf_attn(float f){unsigned u=__float_as_uint(f);return (u+0x7fffu+((u>>16)&1u))>>16;}
#define SBAR() __builtin_amdgcn_sched_barrier(0)
__device__ __forceinline__ void cmask(f32x16&p0,f32x16&p1,int kbase,int qpos,int hi){
  const float NEG=-INFINITY; const int kb=kbase+4*hi-qpos;
  #pragma unroll
  for(int r=0;r<16;++r){int dd=kb+(r&3)+8*(r>>2); if(dd>128||dd<-128)p0[r]=NEG; dd+=32; if(dd>128||dd<-128)p1[r]=NEG;}
}

constexpr int NSLOT=3, SLOTB=8192;
constexpr int LDS_K=0, LDS_V=NSLOT*SLOTB, LDS_WS=2*NSLOT*SLOTB, LDS_OST=LDS_WS+NW*64*4, LDS_BYTES=LDS_OST+NW*4096;
constexpr float C2=0.125f*1.4426950408889634f;
__device__ __forceinline__ void glds16(const void*gsrc,unsigned lds_dst){unsigned keep;
  asm volatile("s_mov_b32 %0, m0\n\ts_mov_b32 m0, %2\n\ts_nop 0\n\tglobal_load_lds_dwordx4 %1, off\n\ts_mov_b32 m0, %0":"=&s"(keep):"v"(gsrc),"s"(lds_dst):"memory");}
__device__ __forceinline__ float max3f(float a,float b,float c){float r;asm("v_max3_f32 %0, %1, %2, %3":"=v"(r):"v"(a),"v"(b),"v"(c));return r;}
__device__ __forceinline__ float max2f(float a,float b){float r;asm("v_max_f32_e32 %0, %1, %2":"=v"(r):"v"(a),"v"(b));return r;}
__device__ __forceinline__ float fadd_s(float a,float b){float r;asm("v_add_f32_e32 %0, %1, %2":"=v"(r):"v"(a),"v"(b));return r;}
__device__ __forceinline__ float fsub_s(float a,float b){float r;asm("v_sub_f32_e32 %0, %1, %2":"=v"(r):"v"(a),"v"(b));return r;}
typedef float f32x2_t __attribute__((ext_vector_type(2))); typedef __bf16 bf16x2_t __attribute__((ext_vector_type(2)));
__device__ __forceinline__ unsigned cvtpk_s(float lo,float hi){f32x2_t v={lo,hi};bf16x2_t b=__builtin_convertvector(v,bf16x2_t);return __builtin_bit_cast(unsigned,b);}
#define WAIT_BAR(N) asm volatile("s_waitcnt vmcnt(" #N ") lgkmcnt(0)\n\ts_barrier":::"memory")

__device__ __forceinline__ void qkt(f32x16&p0,f32x16&p1,const char*Kslot,const bf16x8*qr,const f32x16&negm,int r32,int hi){
  const char*kb=Kslot+hi*1024+r32*16;
  #pragma unroll
  for(int d0=0;d0<4;++d0){
    const bf16x8 b0=*reinterpret_cast<const bf16x8*>(kb+d0*2048);
    const bf16x8 b1=*reinterpret_cast<const bf16x8*>(kb+d0*2048+512);
    if(d0==0){p0=__builtin_amdgcn_mfma_f32_32x32x16_bf16(b0,qr[0],negm,0,0,0);p1=__builtin_amdgcn_mfma_f32_32x32x16_bf16(b1,qr[0],negm,0,0,0);}
    else{p0=__builtin_amdgcn_mfma_f32_32x32x16_bf16(b0,qr[d0],p0,0,0,0);p1=__builtin_amdgcn_mfma_f32_32x32x16_bf16(b1,qr[d0],p1,0,0,0);}}
}
typedef __attribute__((address_space(3))) const char* lds_cptr;
typedef short v4i16_t __attribute__((ext_vector_type(4)));
__device__ __forceinline__ void kload8(bf16x8*kf,lds_cptr kp){
  kf[0]=*(const __attribute__((address_space(3))) bf16x8*)(kp);      kf[1]=*(const __attribute__((address_space(3))) bf16x8*)(kp+512);
  kf[2]=*(const __attribute__((address_space(3))) bf16x8*)(kp+2048); kf[3]=*(const __attribute__((address_space(3))) bf16x8*)(kp+2560);
  kf[4]=*(const __attribute__((address_space(3))) bf16x8*)(kp+4096); kf[5]=*(const __attribute__((address_space(3))) bf16x8*)(kp+4608);
  kf[6]=*(const __attribute__((address_space(3))) bf16x8*)(kp+6144); kf[7]=*(const __attribute__((address_space(3))) bf16x8*)(kp+6656);
}
__device__ __forceinline__ void kload2(bf16x8*kf,lds_cptr kp,int j){ kf[2*j]=*(const __attribute__((address_space(3))) bf16x8*)(kp+j*2048); kf[2*j+1]=*(const __attribute__((address_space(3))) bf16x8*)(kp+j*2048+512); }
__device__ __forceinline__ s16x4 vtr(lds_cptr p){ return __builtin_bit_cast(s16x4,__builtin_amdgcn_ds_read_tr16_b64_v4i16((__attribute__((address_space(3))) v4i16_t*)p)); }
__device__ __forceinline__ float rowmax(const f32x16&p0,const f32x16&p1){
  float a=max3f(p0[0],p0[1],p1[0]),b=max3f(p0[2],p0[3],p1[1]);a=max3f(a,p1[2],p1[3]);
  #pragma unroll
  for(int r=4;r<16;r+=4){a=max3f(a,p0[r],p0[r+1]);b=max3f(b,p0[r+2],p0[r+3]);a=max3f(a,p1[r],p1[r+1]);b=max3f(b,p1[r+2],p1[r+3]);}
  const float m=max2f(a,b);
  auto rr=__builtin_amdgcn_permlane32_swap(__float_as_uint(m),__float_as_uint(m),false,false);
  return max2f(__uint_as_float(rr[0]),__uint_as_float(rr[1]));
}
__device__ __forceinline__ void pv(f32x16*o,int vb,bf16x8 pa0,bf16x8 pa1,bf16x8 pa2,bf16x8 pa3){
  #pragma unroll
  for(int d0=0;d0<2;++d0){s16x4 lo[4],hi[4];
    #pragma unroll
    for(int ks=0;ks<4;++ks){
      asm volatile("ds_read_b64_tr_b16 %0,%1 offset:%c2":"=&v"(lo[ks]):"v"(vb),"i"(d0*4096+ks*1024):"memory");
      asm volatile("ds_read_b64_tr_b16 %0,%1 offset:%c2":"=&v"(hi[ks]):"v"(vb),"i"(d0*4096+ks*1024+512):"memory");}
    asm volatile("s_waitcnt lgkmcnt(0)":::"memory");SBAR();
    #define PK(k) (bf16x8){lo[k][0],lo[k][1],lo[k][2],lo[k][3],hi[k][0],hi[k][1],hi[k][2],hi[k][3]}
    o[d0]=__builtin_amdgcn_mfma_f32_32x32x16_bf16(pa0,PK(0),o[d0],0,0,0);
    o[d0]=__builtin_amdgcn_mfma_f32_32x32x16_bf16(pa1,PK(1),o[d0],0,0,0);
    o[d0]=__builtin_amdgcn_mfma_f32_32x32x16_bf16(pa2,PK(2),o[d0],0,0,0);
    o[d0]=__builtin_amdgcn_mfma_f32_32x32x16_bf16(pa3,PK(3),o[d0],0,0,0);
    #undef PK
  }
}

#ifndef ATTN_STORE16
#define ATTN_STORE16(p,v) (*(u32x4*)(p)=(v))
#endif
template<int THRL, bool NOMAX> __device__ __forceinline__ void attn_unit(const bf16*Qu,const bf16*__restrict__ Kh,const bf16*__restrict__ Vh,unsigned char*Ou,int NT,int extra,bool amode,int qpos0,float sink_l2,char*shm){
  const int tid=threadIdx.x,lane=tid&63,r32=lane&31,hi=lane>>5; const int wid=__builtin_amdgcn_readfirstlane(tid>>6);
  const bf16*Qw=Qu+(long)(wid*QBLK)*QP;
  const unsigned lds0=(unsigned)(uintptr_t)shm;
  float*wsf=(float*)(shm+LDS_WS)+wid*64;
  const bf16*ksrc=Kh+(long)lane*KP+wid*8;
  const bf16*vsrc=Vh+(long)(16*(wid&3)+(lane>>2))*KP+(wid>>2)*32+(lane&3)*8;
  const unsigned kdst=lds0+LDS_K+wid*1024, vdst=lds0+LDS_V+wid*1024;
  #define KOFF(t) ((long)(64*(t)+(((t)>=4)?extra:0))*KP)
  #define DMA_K(t,slot) glds16(ksrc+KOFF(t),(unsigned)__builtin_amdgcn_readfirstlane(kdst+(slot)))
  #define DMA_V(t,slot) glds16(vsrc+KOFF(t),(unsigned)__builtin_amdgcn_readfirstlane(vdst+(slot)))
  const int vb0=(int)(lds0+LDS_V)+((lane>>4)&1)*32+(lane&3)*8+(4*hi+((lane&15)>>2))*64;
  const char*Kbase=shm+LDS_K; bf16x8 kf[8];
  const lds_cptr shm3=(lds_cptr)shm; const lds_cptr kp0=shm3+LDS_K+hi*1024+r32*16; const lds_cptr vp0=shm3+LDS_V+((lane>>4)&1)*32+(lane&3)*8+(4*hi+((lane&15)>>2))*64;
  DMA_K(0,0);DMA_V(0,0);DMA_K(1,SLOTB);
  bf16x8 qr[4];
  #pragma unroll
  for(int d0=0;d0<4;++d0)qr[d0]=*reinterpret_cast<const bf16x8*>(&Qw[(long)r32*QP+d0*16+hi*8]);
  float mhat=0.f,l_reg=0.f;f32x16 o[2];o[0]=f32x16{};o[1]=f32x16{};f32x16 negm=f32x16{};asm volatile("":"+v"(negm));
  const int qpos=qpos0+wid*QBLK+r32;
  #define CMASK(P0,P1,t) do{ if(amode&&(t)>=4)cmask(P0,P1,extra-256+64*(t),qpos,hi);}while(0)
  bool resc=false;
  #define START(P0,P1) do{ resc=false; \
    if(!NOMAX){ const float rm=rowmax(P0,P1); const float dl=rm; mhat=fadd_s(mhat,dl); \
      _Pragma("unroll") for(int r=0;r<16;++r){P0[r]=fsub_s(P0[r],dl);P1[r]=fsub_s(P1[r],dl);} \
      _Pragma("unroll") for(int r=0;r<16;++r)negm[r]=-mhat; asm volatile("":"+v"(negm)); } \
    _Pragma("unroll") for(int r=0;r<16;++r)P0[r]=__builtin_amdgcn_exp2f(P0[r]); }while(0)
  #define RESC() do{ if(resc){ asm volatile("s_waitcnt lgkmcnt(0)":::"memory"); \
      _Pragma("unroll") for(int d_=0;d_<2;++d_) _Pragma("unroll") for(int r=0;r<16;++r)o[d_][r]*=wsf[crow(r,hi)]; } }while(0)
  f32x16 pA0,pA1,pB0,pB1;
  int sl_prev=0,sl_cur=0,sl_next=SLOTB;
  #define ROT() do{sl_prev=sl_cur;sl_cur=sl_next;sl_next=(sl_next==(NSLOT-1)*SLOTB)?0:sl_next+SLOTB;}while(0)
  DMA_K(2,2*SLOTB);
  WAIT_BAR(3);
  qkt(pA0,pA1,Kbase,qr,negm,r32,hi);asm volatile("s_nop 15\n\ts_nop 7":"+v"(pA0),"+v"(pA1));CMASK(pA0,pA1,0);
  START(pA0,pA1);
  _Pragma("unroll") for(int r=0;r<16;++r)pA1[r]=__builtin_amdgcn_exp2f(pA1[r]);
  WAIT_BAR(0);
  DMA_K(3,0);DMA_V(1,SLOTB);
  ROT();
  kload8(kf,kp0+sl_cur);
  WAIT_BAR(2);
  s16x4 vlo[8],vhi[8]; u32x4 pw0,pw1,pw2,pw3;
  #define PKW(P,B) cvtpk_s(P[B],P[B+1])
  #define PAF(k) __builtin_bit_cast(bf16x8,pw##k)
  #define VFR(i) (bf16x8){vlo[i][0],vlo[i][1],vlo[i][2],vlo[i][3],vhi[i][0],vhi[i][1],vhi[i][2],vhi[i][3]}
  #define PIN(x) asm volatile("":"+v"(x))
  #define MX3(a,b,c) __builtin_fmaxf(__builtin_fmaxf((a),(b)),(c))
  #define GAPA(MF,A0,A1,A2,A3,W0,W1,PW) do{ MF; sacc+=A0; sacc+=A1; sacc+=A2; sacc+=A3; PIN(sacc); W0; W1; PIN(PW); SBAR(); }while(0)
  #define EX(v) __builtin_amdgcn_exp2f(v)
  #define GAPB(MF,X,B) do{ MF; X[B]=EX(X[B]); X[B+1]=EX(X[B+1]); X[B+2]=EX(X[B+2]); X[B+3]=EX(X[B+3]); PIN(X); SBAR(); }while(0)
  #define VRD(i) do{ vlo[i]=vtr(vp_+(((i)>>2)*4096+((i)&3)*1024)); vhi[i]=vtr(vp_+(((i)>>2)*4096+((i)&3)*1024+512)); }while(0)
  #define KRD(G,j) do{ if(G){ kload2(kf,kp0+sl_next,j); SBAR(); } }while(0)
  #define STEP(C0,C1,P0,P1,t,GK,GV,GL) do{ SBAR(); \
    const lds_cptr vp_=vp0+sl_prev; \
    VRD(0); SBAR(); float sacc=(P0[0]+P0[1]); \
    GAPA(C0=__builtin_amdgcn_mfma_f32_32x32x16_bf16(kf[0],qr[0],negm,0,0,0), P0[2],P0[3],P0[4],P0[5],     pw0[0]=PKW(P0,0), pw0[1]=PKW(P0,2), pw0); \
    VRD(4); SBAR(); GAPA(C1=__builtin_amdgcn_mfma_f32_32x32x16_bf16(kf[1],qr[0],negm,0,0,0), P0[6],P0[7],P0[8],P0[9],     pw0[2]=PKW(P0,4), pw0[3]=PKW(P0,6), pw0); \
    VRD(1); SBAR(); GAPA(C0=__builtin_amdgcn_mfma_f32_32x32x16_bf16(kf[2],qr[1],C0,0,0,0),   P0[10],P0[11],P0[12],P0[13], pw1[0]=PKW(P0,8), pw1[1]=PKW(P0,10), pw1); \
    VRD(5); SBAR(); GAPA(C1=__builtin_amdgcn_mfma_f32_32x32x16_bf16(kf[3],qr[1],C1,0,0,0),   P0[14],P0[15],P1[0],P1[1],   pw1[2]=PKW(P0,12),pw1[3]=PKW(P0,14), pw1); \
    VRD(2); SBAR(); GAPA(C0=__builtin_amdgcn_mfma_f32_32x32x16_bf16(kf[4],qr[2],C0,0,0,0),   P1[2],P1[3],P1[4],P1[5],     pw2[0]=PKW(P1,0), pw2[1]=PKW(P1,2), pw2); \
    VRD(6); SBAR(); GAPA(C1=__builtin_amdgcn_mfma_f32_32x32x16_bf16(kf[5],qr[2],C1,0,0,0),   P1[6],P1[7],P1[8],P1[9],     pw2[2]=PKW(P1,4), pw2[3]=PKW(P1,6), pw2); \
    VRD(3); SBAR(); GAPA(C0=__builtin_amdgcn_mfma_f32_32x32x16_bf16(kf[6],qr[3],C0,0,0,0),   P1[10],P1[11],P1[12],P1[13], pw3[0]=PKW(P1,8), pw3[1]=PKW(P1,10), pw3); \
    VRD(7); SBAR(); GAPA(C1=__builtin_amdgcn_mfma_f32_32x32x16_bf16(kf[7],qr[3],C1,0,0,0),   P1[14],P1[15],0.f,0.f,       pw3[2]=PKW(P1,12),pw3[3]=PKW(P1,14), pw3); \
    l_reg+=sacc; \
    if(GK){DMA_K((t)+3,sl_cur);} if(GV){DMA_V((t)+1,sl_next);} \
    CMASK(C0,C1,t); \
    if(!NOMAX){ float a=MX3(C0[0],C0[1],C1[0]),b=MX3(C0[2],C0[3],C1[1]); a=MX3(a,C1[2],C1[3]); \
      _Pragma("unroll") for(int r=4;r<16;r+=4){a=MX3(a,C0[r],C0[r+1]);b=MX3(b,C0[r+2],C0[r+3]);a=MX3(a,C1[r],C1[r+1]);b=MX3(b,C1[r+2],C1[r+3]);} \
      float rm=__builtin_fmaxf(a,b); { auto rr=__builtin_amdgcn_permlane32_swap(__float_as_uint(rm),__float_as_uint(rm),false,false); rm=__builtin_fmaxf(__uint_as_float(rr[0]),__uint_as_float(rr[1])); } \
      resc=false; \
      if(__builtin_expect(__any(rm>(float)THRL),0)){ const float dl=__builtin_fmaxf(rm,0.f); mhat+=dl; \
        _Pragma("unroll") for(int r=0;r<16;++r){C0[r]-=dl;C1[r]-=dl;} \
        _Pragma("unroll") for(int r=0;r<16;++r)negm[r]=-mhat; asm volatile("":"+v"(negm)); \
        const float f=__builtin_amdgcn_exp2f(-dl); l_reg*=f; if(hi==0)wsf[r32]=f; resc=true; } } \
    SBAR(); \
    GAPB(o[0]=__builtin_amdgcn_mfma_f32_32x32x16_bf16(PAF(0),VFR(0),o[0],0,0,0), C0,0); \
    GAPB(o[1]=__builtin_amdgcn_mfma_f32_32x32x16_bf16(PAF(0),VFR(4),o[1],0,0,0), C0,4); \
    KRD(GL,0); GAPB(o[0]=__builtin_amdgcn_mfma_f32_32x32x16_bf16(PAF(1),VFR(1),o[0],0,0,0), C0,8); \
    KRD(GL,1); GAPB(o[1]=__builtin_amdgcn_mfma_f32_32x32x16_bf16(PAF(1),VFR(5),o[1],0,0,0), C0,12); \
    KRD(GL,2); GAPB(o[0]=__builtin_amdgcn_mfma_f32_32x32x16_bf16(PAF(2),VFR(2),o[0],0,0,0), C1,0); \
    KRD(GL,3); GAPB(o[1]=__builtin_amdgcn_mfma_f32_32x32x16_bf16(PAF(2),VFR(6),o[1],0,0,0), C1,4); \
    GAPB(o[0]=__builtin_amdgcn_mfma_f32_32x32x16_bf16(PAF(3),VFR(3),o[0],0,0,0), C1,8); \
    GAPB(o[1]=__builtin_amdgcn_mfma_f32_32x32x16_bf16(PAF(3),VFR(7),o[1],0,0,0), C1,12); \
    }while(0)
  int t=1;
  for(;t+5<NT;t+=2){
    STEP(pB0,pB1,pA0,pA1,t,true,true,true);     WAIT_BAR(2); RESC(); ROT();
    STEP(pA0,pA1,pB0,pB1,t+1,true,true,true);   WAIT_BAR(2); RESC(); ROT();
  }
  #define ENDW(tt) do{ if((tt)+3<NT){WAIT_BAR(2);} else if((tt)+2<NT){WAIT_BAR(1);} else {WAIT_BAR(0);} }while(0)
  for(;t+1<NT;t+=2){
    STEP(pB0,pB1,pA0,pA1,t,(t+3<NT),(t+1<NT),(t+1<NT));       ENDW(t);   RESC(); ROT();
    STEP(pA0,pA1,pB0,pB1,t+1,(t+4<NT),(t+2<NT),(t+2<NT));     ENDW(t+1); RESC(); ROT();
  }
  STEP(pB0,pB1,pA0,pA1,NT-1,false,false,false); RESC();
  { float sacc=pB0[0]+pB0[1]; _Pragma("unroll") for(int r=2;r<16;++r)sacc+=pB0[r]; _Pragma("unroll") for(int r=0;r<16;++r)sacc+=pB1[r]; l_reg+=sacc;
    pw0=(u32x4){PKW(pB0,0),PKW(pB0,2),PKW(pB0,4),PKW(pB0,6)};pw1=(u32x4){PKW(pB0,8),PKW(pB0,10),PKW(pB0,12),PKW(pB0,14)};pw2=(u32x4){PKW(pB1,0),PKW(pB1,2),PKW(pB1,4),PKW(pB1,6)};pw3=(u32x4){PKW(pB1,8),PKW(pB1,10),PKW(pB1,12),PKW(pB1,14)};
    SBAR(); pv(o,vb0+sl_cur,PAF(0),PAF(1),PAF(2),PAF(3)); }
  #undef PKW
  #undef PAF
  #undef VFR
  #undef PIN
  #undef MX3
  #undef GAPA
  #undef GAPB
  #undef EX
  #undef VRD
  #undef KRD
  #undef STEP
  #undef ENDW
  {auto rr=__builtin_amdgcn_permlane32_swap(__float_as_uint(l_reg),__float_as_uint(l_reg),false,false);l_reg=__uint_as_float(rr[0])+__uint_as_float(rr[1]);}
  l_reg+=__builtin_amdgcn_exp2f(sink_l2-mhat);
  if(hi==0)wsf[32+r32]=l_reg;asm volatile("s_waitcnt lgkmcnt(0)":::"memory");
  float rli[16];
  #pragma unroll
  for(int r=0;r<16;++r)rli[r]=__builtin_amdgcn_rcpf(wsf[32+crow(r,hi)]);
  unsigned char*Ow=Ou+(long)(wid*QBLK)*QP;
  { bf16*stg=(bf16*)(shm+LDS_OST)+wid*2048;
    #pragma unroll
    for(int r=0;r<16;++r){const int orow=crow(r,hi);
      #pragma unroll
      for(int d0=0;d0<2;++d0)stg[orow*64+d0*32+r32]=(bf16)f2bf_attn(o[d0][r]*rli[r]);}
    asm volatile("s_waitcnt lgkmcnt(0)":::"memory");
    #pragma unroll
    for(int i=0;i<4;++i){const int row=i*8+(lane>>3),ch=lane&7; const u32x4 v=*(const u32x4*)(stg+row*64+ch*8);
      #define O8C(w_,hi_) fminf(fmaxf(__uint_as_float((hi_)?((w_)&0xffff0000u):((w_)<<16))*O8_SCALE,-448.f),448.f)
      int w0=0,w1=0;
      w0=__builtin_amdgcn_cvt_pk_fp8_f32(O8C(v.x,0),O8C(v.x,1),w0,false);w0=__builtin_amdgcn_cvt_pk_fp8_f32(O8C(v.y,0),O8C(v.y,1),w0,true);
      w1=__builtin_amdgcn_cvt_pk_fp8_f32(O8C(v.z,0),O8C(v.z,1),w1,false);w1=__builtin_amdgcn_cvt_pk_fp8_f32(O8C(v.w,0),O8C(v.w,1),w1,true);
      #undef O8C
      u32x2 w;w.x=(unsigned)w0;w.y=(unsigned)w1;*(u32x2*)(Ow+(long)row*QP+ch*8)=w;} }
  asm volatile("s_waitcnt lgkmcnt(0)\n\ts_barrier":::"memory");
  #undef DMA_K
  #undef KOFF
  #undef DMA_V
  #undef CMASK
  #undef START
  #undef RESC
  #undef ROT
}
constexpr int ATTN_LDS_BYTES=LDS_BYTES;
#undef SBAR
#undef WAIT_BAR
}

DEVINL void phase_attn(const Params& p, char* smem) {
    const bf16_t* Q = (const bf16_t*)(p.ws + WS_R2);
    const bf16_t* KA = (const bf16_t*)(p.ws + WS_R3); const bf16_t* VA = KA + (size_t)NB * KVR * 128; const bf16_t* KB = VA + (size_t)NB * KVR * 128; const bf16_t* VB = KB + (size_t)NB * KVR * 128;
    unsigned char* O = p.ws + WS_R4;
    const int G = gridDim.x, vcu = (G % 8 == 0) ? (blockIdx.x % 8) * (G / 8) + blockIdx.x / 8 : blockIdx.x;
    float gq = 0.f, gk = 0.f;
    for (int i = 0; i < 64; ++i) { gq = fmaxf(gq, fabsf(p.in[10][i])); gk = fmaxf(gk, fabsf(p.in[11][i])); }
    const bool bounded = (8.f * gq * gk * LOG2E) < 40.f;
    for (int v = vcu; v < 256; v += G) {
        const int p8 = v >> 5, c32 = v & 31, b = p8 >> 1, kvh = p8 & 1;
        for (int i = 0; i < 9; ++i) {
            int typeB, g, NT, extra, qpos0; bool amode; size_t qrow0;
            if (i < 4) { typeB = 1; g = i; NT = 132; extra = 0; amode = false; qpos0 = c32 * 256; qrow0 = (size_t)b * SEQ + qpos0; }
            else if (i < 8) {
                typeB = 0; g = i - 4; qpos0 = c32 * 256; qrow0 = (size_t)b * SEQ + qpos0; amode = true;
                const int lo = qpos0 - 128 < 0 ? 0 : qpos0 - 128, hi = qpos0 + 384 > SEQ ? SEQ : qpos0 + 384;
                NT = 4 + (hi - lo) / 64; extra = lo;
            } else { if (c32 >= 8) break; typeB = c32 >> 2; g = c32 & 3; NT = 4; extra = 0; amode = false; qpos0 = 0; qrow0 = (size_t)TLAT + b * CTX; }
            const int hq = kvh * 4 + g, hcol = (typeB ? 512 : 0) + hq * 64;
            const float sink = typeB ? -INFINITY : p.in[9][hq] * LOG2E;
            const bf16_t* Kh = (typeB ? KB : KA) + (size_t)b * KVR * 128 + kvh * 64;
            const bf16_t* Vh = (typeB ? VB : VA) + (size_t)b * KVR * 128 + kvh * 64;
            if (typeB && bounded) attn_body::attn_unit<8, true>(Q + qrow0 * 1024 + hcol, Kh, Vh, O + qrow0 * 1024 + hcol, NT, extra, amode, qpos0, sink, smem);
            else attn_body::attn_unit<8, false>(Q + qrow0 * 1024 + hcol, Kh, Vh, O + qrow0 * 1024 + hcol, NT, extra, amode, qpos0, sink, smem);
        }
    }
}

__device__ const unsigned char PAIR_A[52] = {0,0,0,0,0,0,0,0,0,0,0,0,0,0,0,0, 1,1,1,1,1,1,1,1, 2,2,2,2,2, 3,3,3,3, 4,4,4, 5,5, 6,6, 7,7, 8,9,10,11,12,13,14,15, 0,0};
__device__ const unsigned char PAIR_B[52] = {0,1,2,3,4,5,6,7,8,9,10,11,12,13,14,15, 0,1,2,3,4,5,6,7, 0,1,2,3,4, 0,1,2,3, 0,1,2, 0,1, 0,1, 0,1, 0,0,0,0,0,0,0,0, 0,0};
DEVINL int f2sort(float f) { int s = __float_as_int(f); return s ^ ((s >> 31) & 0x7fffffff); }
DEVINL float sort2f(int s) { return __int_as_float(s ^ ((s >> 31) & 0x7fffffff)); }
DEVINL void bsort16_desc(int (&v)[16]) {
#define CE(a_, b_) do { const int hi_ = max(v[a_], v[b_]), lo_ = min(v[a_], v[b_]); v[a_] = hi_; v[b_] = lo_; } while (0)
    CE(0,13); CE(1,12); CE(2,15); CE(3,14); CE(4,8); CE(5,6); CE(7,11); CE(9,10);
    CE(0,5); CE(1,7); CE(2,9); CE(3,4); CE(6,13); CE(8,14); CE(10,15); CE(11,12);
    CE(0,1); CE(2,3); CE(4,5); CE(6,8); CE(7,9); CE(10,11); CE(12,13); CE(14,15);
    CE(0,2); CE(1,3); CE(4,10); CE(5,11); CE(6,7); CE(8,9); CE(12,14); CE(13,15);
    CE(1,2); CE(3,12); CE(4,6); CE(5,7); CE(8,10); CE(9,11); CE(13,14);
    CE(1,4); CE(2,6); CE(5,8); CE(7,10); CE(9,13); CE(11,14);
    CE(2,4); CE(3,6); CE(9,12); CE(11,13);
    CE(3,5); CE(6,8); CE(7,9); CE(10,12);
    CE(3,4); CE(5,6); CE(7,8); CE(9,10); CE(11,12);
    CE(6,7); CE(8,9);
#undef CE
}
DEVINL void bmerge16_desc(int (&v)[16]) {
#pragma unroll
    for (int j = 8; j > 0; j >>= 1)
#pragma unroll
        for (int i = 0; i < 16; ++i) { const int l = i ^ j; if (l > i) { const int hi = max(v[i], v[l]), lo = min(v[i], v[l]); v[i] = hi; v[l] = lo; } }
}
DEVINL void top16_of_4x32(const int (&pv)[32], int (&t)[16]) {
    int a[16], b[16];
#pragma unroll
    for (int i = 0; i < 16; ++i) { a[i] = pv[i]; b[i] = pv[16 + i]; }
    bsort16_desc(a); bsort16_desc(b);
#pragma unroll
    for (int i = 0; i < 16; ++i) t[i] = max(a[i], b[15 - i]);
    bmerge16_desc(t);
#pragma unroll
    for (int lvl = 16; lvl <= 32; lvl <<= 1) {
        int o[16];
#pragma unroll
        for (int i = 0; i < 16; ++i) o[i] = __shfl_xor(t[15 - i], lvl);
#pragma unroll
        for (int i = 0; i < 16; ++i) t[i] = max(t[i], o[i]);
        bmerge16_desc(t);
    }
}
DEVINL void top16_lane(const int (&pv)[32], int (&t)[16]) {
    int a[16], b[16];
#pragma unroll
    for (int i = 0; i < 16; ++i) { a[i] = pv[i]; b[i] = pv[16 + i]; }
    bsort16_desc(a); bsort16_desc(b);
#pragma unroll
    for (int i = 0; i < 16; ++i) t[i] = max(a[i], b[15 - i]);
    bmerge16_desc(t);
}
DEVINL void merge_groups(const int (&g0)[16], const int (&g1)[16], int (&m)[16]) {
    int x[16], y[16];
#pragma unroll
    for (int i = 0; i < 16; ++i) { auto rr = __builtin_amdgcn_permlane32_swap((unsigned)g0[i], (unsigned)g1[i], false, false); x[i] = (int)rr[0]; y[i] = (int)rr[1]; }
#pragma unroll
    for (int i = 0; i < 16; ++i) m[i] = max(x[i], y[15 - i]);
    bmerge16_desc(m);
    int o[16];
#pragma unroll
    for (int i = 0; i < 16; ++i) o[i] = __shfl_xor(m[15 - i], 16);
#pragma unroll
    for (int i = 0; i < 16; ++i) m[i] = max(m[i], o[i]);
    bmerge16_desc(m);
}
constexpr int TOPK_PTAB_OFF = 33792;
DEVINL const int* topk_pairs_init(char* smem) {
    int* ptab = (int*)(smem + TOPK_PTAB_OFF);
    if (threadIdx.x < 52) ptab[threadIdx.x] = (int)PAIR_A[threadIdx.x] | ((int)PAIR_B[threadIdx.x] << 4);
    __syncthreads();
    return ptab;
}
template <class OUT>
DEVINL void topk_combine(const int* scr, int lane, const int* ptab, int h, const OUT& out) {
    const int l15 = lane & 15, lq = lane >> 4;
    int win[16];
#pragma unroll
    for (int i = 0; i < 16; ++i) {
        if (i < 13) {
            const int ab = ptab[lq * 13 + i], a = ab & 15, b = ab >> 4;
            const float sv = sort2f(scr[l15 * 33 + a] & ~127) + sort2f(scr[l15 * 33 + 16 + b] & ~127);
            win[i] = (f2sort(sv) & ~255) | ab;
            if (i >= 11) { const int im = -(int)(lq * 13 + i >= 50); win[i] = (win[i] & ~im) | (im & (int)0x80000000); }
        } else win[i] = (int)0x80000000;
    }
    bsort16_desc(win);
#pragma unroll
    for (int lvl = 16; lvl <= 32; lvl <<= 1) {
        int o[16];
#pragma unroll
        for (int i = 0; i < 16; ++i) o[i] = __shfl_xor(win[15 - i], lvl);
#pragma unroll
        for (int i = 0; i < 16; ++i) win[i] = max(win[i], o[i]);
        bmerge16_desc(win);
    }
    const float v0 = sort2f(win[0] & ~255);
    float ev[16], den = 0.f;
#pragma unroll
    for (int r = 0; r < 16; ++r) { ev[r] = fexp(sort2f(win[r] & ~255) - v0); den += ev[r]; }
    const float rden = __builtin_amdgcn_rcpf(den);
    if (lq == 0) {
#pragma unroll
        for (int r = 0; r < 16; ++r) {
            const int e = (scr[l15 * 33 + (win[r] & 15)] & 127) * 128 + (scr[l15 * 33 + 16 + ((win[r] >> 4) & 15)] & 127);
            out(l15, h * 16 + r, e, ev[r] * rden);
        }
    }
    __builtin_amdgcn_fence(__ATOMIC_RELEASE, "wavefront"); __builtin_amdgcn_wave_barrier(); __builtin_amdgcn_fence(__ATOMIC_ACQUIRE, "wavefront");
}
DEVINL float key2f(int v) { const int x = v & (int)0xffff0000; return __int_as_float(x ^ ((x >> 31) & 0x7fff0000)); }
template <class OUT>
DEVINL void topk_combine2(const int* scr, int lane, const int* ptab, int h, const OUT& out0, const OUT& out1) {
    const int l15 = lane & 15, lq = lane >> 4;
    int w0[16], w1[16], win[16];
#pragma unroll
    for (int i = 0; i < 16; ++i) {
        if (i < 13) {
            const int ab = ptab[lq * 13 + i], a = ab & 15, b = ab >> 4;
            const float s0 = key2f(scr[l15 * 33 + a]) + key2f(scr[l15 * 33 + 16 + b]);
            const float s1 = key2f(scr[528 + l15 * 33 + a]) + key2f(scr[528 + l15 * 33 + 16 + b]);
            w0[i] = (f2sort(s0) & ~255) | ab; w1[i] = (f2sort(s1) & ~255) | ab;
            if (i >= 11) { const int im = -(int)(lq * 13 + i >= 50); w0[i] = (w0[i] & ~im) | (im & (int)0x80000000); w1[i] = (w1[i] & ~im) | (im & (int)0x80000000); }
        } else { w0[i] = (int)0x80000000; w1[i] = (int)0x80000000; }
    }
    bsort16_desc(w0); bsort16_desc(w1);
    merge_groups(w0, w1, win);
    const int* sg = scr + (lq >> 1) * 528;
    const float v0 = sort2f(win[0] & ~255);
    float ev[16], den = 0.f;
#pragma unroll
    for (int r = 0; r < 16; ++r) { ev[r] = fexp(sort2f(win[r] & ~255) - v0); den += ev[r]; }
    const float rden = __builtin_amdgcn_rcpf(den);
    if ((lq & 1) == 0) {
#pragma unroll
        for (int r = 0; r < 16; ++r) {
            const int e = (sg[l15 * 33 + (win[r] & 15)] & 127) * 128 + (sg[l15 * 33 + 16 + ((win[r] >> 4) & 15)] & 127);
            if (lq == 0) out0(l15, h * 16 + r, e, ev[r] * rden); else out1(l15, h * 16 + r, e, ev[r] * rden);
        }
    }
    __builtin_amdgcn_fence(__ATOMIC_RELEASE, "wavefront"); __builtin_amdgcn_wave_barrier(); __builtin_amdgcn_fence(__ATOMIC_ACQUIRE, "wavefront");
}
struct TopkQ { bf16x8 q0[4], q1[4]; };
DEVINL void topk_load_q(const bf16_t* Qp, int tok0, int h, int lane, TopkQ& Q) {
    const bf16_t* qb = Qp + (size_t)(tok0 + (lane & 15)) * 2048 + h * 256 + (lane >> 4) * 8;
#pragma unroll
    for (int kk = 0; kk < 4; ++kk) { Q.q0[kk] = *(const bf16x8*)(qb + kk * 32); Q.q1[kk] = *(const bf16x8*)(qb + 128 + kk * 32); }
}
template <int KSTR, class OUT, bool QREG>
DEVINL void topk_task(TopkQ& Q, const bf16_t* qb  , const bf16_t* keys_h  , int h, int* scr, int lane, const int* pab, const OUT& out,
                      const bf16_t* Qp_next = nullptr, int tok0 = 0) {
    const int l15 = lane & 15, lq = lane >> 4;
    f32x4 acc0[8], acc1[8];
#pragma unroll
    for (int i = 0; i < 8; ++i) { acc0[i] = (f32x4){0.f, 0.f, 0.f, 0.f}; acc1[i] = acc0[i]; }
    const bf16_t* kb = keys_h + (size_t)l15 * KSTR + lq * 8;
#define TOPK_KSTEP(kk_, bq0_, bq1_) do { bf16x8 ak0[8], ak1[8]; \
        _Pragma("unroll") for (int i = 0; i < 8; ++i) { ak0[i] = *(const bf16x8*)(kb + (size_t)i * 16 * KSTR + (kk_) * 32); ak1[i] = *(const bf16x8*)(kb + (size_t)(128 + i * 16) * KSTR + (kk_) * 32); } \
        _Pragma("unroll") for (int i = 0; i < 8; ++i) { acc0[i] = __builtin_amdgcn_mfma_f32_16x16x32_bf16(ak0[i], bq0_, acc0[i], 0, 0, 0); acc1[i] = __builtin_amdgcn_mfma_f32_16x16x32_bf16(ak1[i], bq1_, acc1[i], 0, 0, 0); } } while (0)
    if constexpr (QREG) {
#pragma unroll
        for (int kk = 0; kk < 4; ++kk) { TOPK_KSTEP(kk, Q.q0[kk], Q.q1[kk]); asm volatile("" ::: "memory"); }
    } else {
#pragma unroll 1
        for (int kk = 0; kk < 4; ++kk) { const bf16x8 bq0 = *(const bf16x8*)(qb + kk * 32), bq1 = *(const bf16x8*)(qb + 128 + kk * 32); TOPK_KSTEP(kk, bq0, bq1); }
    }
#undef TOPK_KSTEP
    if constexpr (QREG) { if (Qp_next) topk_load_q(Qp_next, tok0, h + 1, lane, Q); }
    int pv0[32], pv1[32];
#pragma unroll
    for (int i = 0; i < 8; ++i)
#pragma unroll
        for (int j = 0; j < 4; ++j) { pv0[i * 4 + j] = (f2sort(acc0[i][j]) & ~127) | (i * 16 + lq * 4 + j); pv1[i * 4 + j] = (f2sort(acc1[i][j]) & ~127) | (i * 16 + lq * 4 + j); }
    {
        int t0[16], t1[16];
        top16_of_4x32(pv0, t0); top16_of_4x32(pv1, t1);
        if (lq == 0) {
#pragma unroll
            for (int r = 0; r < 16; ++r) { scr[l15 * 33 + r] = t0[r]; scr[l15 * 33 + 16 + r] = t1[r]; }
        }
    }
    __builtin_amdgcn_fence(__ATOMIC_RELEASE, "wavefront"); __builtin_amdgcn_wave_barrier(); __builtin_amdgcn_fence(__ATOMIC_ACQUIRE, "wavefront");
    topk_combine(scr, lane, pab, h, out);
}
struct TopkQ2 { bf16x8 q[2][4]; };
DEVINL void topk_load_q2(const bf16_t* Qp, int tok0, int h, int half, int lane, TopkQ2& Q) {
    const bf16_t* qb = Qp + (size_t)(tok0 + (lane & 15)) * 2048 + h * 256 + half * 128 + (lane >> 4) * 8;
#pragma unroll
    for (int g = 0; g < 2; ++g)
#pragma unroll
        for (int kk = 0; kk < 4; ++kk) Q.q[g][kk] = *(const bf16x8*)(qb + (size_t)g * 16 * 2048 + kk * 32);
}
template <int KSTR>
DEVINL void topk_scores2(const TopkQ2& Q, const bf16_t* keys_hh  , f32x4 (&acc)[2][8], int lane) {
    const int l15 = lane & 15, lq = lane >> 4;
#pragma unroll
    for (int g = 0; g < 2; ++g)
#pragma unroll
        for (int i = 0; i < 8; ++i) acc[g][i] = (f32x4){0.f, 0.f, 0.f, 0.f};
    const bf16_t* kb = keys_hh + (size_t)l15 * KSTR + lq * 8;
#pragma unroll
    for (int kk = 0; kk < 4; ++kk) {
        bf16x8 ak[8];
#pragma unroll
        for (int i = 0; i < 8; ++i) ak[i] = *(const bf16x8*)(kb + (size_t)i * 16 * KSTR + kk * 32);
#pragma unroll
        for (int i = 0; i < 8; ++i) { acc[0][i] = __builtin_amdgcn_mfma_f32_16x16x32_bf16(ak[i], Q.q[0][kk], acc[0][i], 0, 0, 0); acc[1][i] = __builtin_amdgcn_mfma_f32_16x16x32_bf16(ak[i], Q.q[1][kk], acc[1][i], 0, 0, 0); }
        asm volatile("" ::: "memory");
    }
}
DEVINL void topk_select2(const f32x4 (&acc)[2][8], int half, int* scr, int lane) {
    const int l15 = lane & 15, lq = lane >> 4;
    int pv0[32], pv1[32];
#pragma unroll
    for (int i = 0; i < 8; ++i)
#pragma unroll
        for (int j = 0; j < 4; ++j) { pv0[i * 4 + j] = (f2sort(acc[0][i][j]) & ~127) | (i * 16 + lq * 4 + j); pv1[i * 4 + j] = (f2sort(acc[1][i][j]) & ~127) | (i * 16 + lq * 4 + j); }
    int t0[16], t1[16], m[16];
    top16_lane(pv0, t0); top16_lane(pv1, t1);
    merge_groups(t0, t1, m);
    if ((lq & 1) == 0) {
        int* dst = scr + (lq >> 1) * 528 + l15 * 33 + half * 16;
#pragma unroll
        for (int r = 0; r < 16; ++r) dst[r] = m[r];
    }
}
struct TopkOutGlobal { unsigned* GX; int tok0; DEVINL void operator()(int tl, int slot, int e, float g) const { GX[(size_t)(tok0 + tl) * 128 + slot] = pk2(0.f, g) | (unsigned)e; } };
struct TopkOutLds { unsigned short* ex; float* gt; DEVINL void operator()(int tl, int slot, int e, float g) const { ex[tl * 128 + slot] = (unsigned short)e; gt[tl * 128 + slot] = g; } };
DEVINL void phase_topk(const Params& p, int layer, int row_lo, int row_hi, char* smem) {
    const int tid = threadIdx.x, lane = tid & 63, wid = tid >> 6;
    int* scr = (int*)smem + wid * 544;
    const bf16_t* Qp = (const bf16_t*)(p.ws + WS_R4);
    const bf16_t* keys = (const bf16_t*)(p.ws + WS_KEYS) + (size_t)layer * 8 * 2 * 128 * 128;
    unsigned* GX = (unsigned*)(p.ws + WS_R2);
    const int ntask = ((row_hi - row_lo) / 16) * 8, gw = blockIdx.x * NWAVES + wid, ngw = gridDim.x * NWAVES;
    const int* pab = topk_pairs_init(smem);
    for (int task = gw; task < ntask; task += ngw) {
        const int h = task & 7, tok0 = row_lo + (task >> 3) * 16;
        TopkQ Q;
        topk_task<128, TopkOutGlobal, false>(Q, Qp + (size_t)(tok0 + (lane & 15)) * 2048 + h * 256 + (lane >> 4) * 8, keys + (size_t)h * 2 * 128 * 128, h, scr, lane, pab, TopkOutGlobal{GX, tok0});
    }
}

constexpr float U8_SCALE = 1024.f, V8_SCALE = 32.f;
typedef float f32x2v __attribute__((ext_vector_type(2)));
DEVINL void dec16(const u32x4 w, float* t) {
    f32x2v r;
    r = __builtin_amdgcn_cvt_pk_f32_fp8((int)w.x, false); t[0] = r.x; t[1] = r.y; r = __builtin_amdgcn_cvt_pk_f32_fp8((int)w.x, true); t[2] = r.x; t[3] = r.y;
    r = __builtin_amdgcn_cvt_pk_f32_fp8((int)w.y, false); t[4] = r.x; t[5] = r.y; r = __builtin_amdgcn_cvt_pk_f32_fp8((int)w.y, true); t[6] = r.x; t[7] = r.y;
    r = __builtin_amdgcn_cvt_pk_f32_fp8((int)w.z, false); t[8] = r.x; t[9] = r.y; r = __builtin_amdgcn_cvt_pk_f32_fp8((int)w.z, true); t[10] = r.x; t[11] = r.y;
    r = __builtin_amdgcn_cvt_pk_f32_fp8((int)w.w, false); t[12] = r.x; t[13] = r.y; r = __builtin_amdgcn_cvt_pk_f32_fp8((int)w.w, true); t[14] = r.x; t[15] = r.y;
}
DEVINL float clamp8(float x) { return fminf(fmaxf(x, -448.f), 448.f); }
DEVINL void convert_flat_fp8(const float* src, unsigned char* dst, size_t n, float scale) {
    const size_t nth = (size_t)gridDim.x * NTHREADS;
    for (size_t i = (size_t)blockIdx.x * NTHREADS + threadIdx.x; i < n / 16; i += nth) {
        u32x4 o;
#pragma unroll
        for (int q = 0; q < 4; ++q) {
            const f32x4 a = *(const f32x4*)(src + i * 16 + q * 4);
            int w = 0;
            w = __builtin_amdgcn_cvt_pk_fp8_f32(clamp8(a.x * scale), clamp8(a.y * scale), w, false);
            w = __builtin_amdgcn_cvt_pk_fp8_f32(clamp8(a.z * scale), clamp8(a.w * scale), w, true);
            o[q] = (unsigned)w;
        }
        *(u32x4*)(dst + i * 16) = o;
    }
}
DEVINL void convert_v_sliced_fp8(const float* src, unsigned char* dst, float scale) {
    const size_t nth = (size_t)gridDim.x * NTHREADS, nitems = (size_t)16384 * 1024 / 16;
    for (size_t i = (size_t)blockIdx.x * NTHREADS + threadIdx.x; i < nitems; i += nth) {
        u32x4 o;
#pragma unroll
        for (int q = 0; q < 4; ++q) {
            const f32x4 a = *(const f32x4*)(src + i * 16 + q * 4);
            int w = 0;
            w = __builtin_amdgcn_cvt_pk_fp8_f32(clamp8(a.x * scale), clamp8(a.y * scale), w, false);
            w = __builtin_amdgcn_cvt_pk_fp8_f32(clamp8(a.z * scale), clamp8(a.w * scale), w, true);
            o[q] = (unsigned)w;
        }
        const size_t e = i >> 6; const int c0 = (int)(i & 63) * 16;
        *(u32x4*)(dst + (size_t)(c0 >> 7) * ((size_t)16384 * 128) + e * 128 + (c0 & 127)) = o;
    }
}
DEVINL unsigned char* tab8(const Params& p, int layer) { return (unsigned char*)p.out + (layer == 0 ? (size_t)0 : (size_t)96 * MiB); }
DEVINL void vslice_token(const unsigned char* V8s, int lane, unsigned x0, unsigned x1  , float* acc2  ) {
    const int es = lane >> 3, ck = lane & 7;
    float acc[16];
#pragma unroll
    for (int i = 0; i < 16; ++i) acc[i] = 0.f;
    u32x4 w[16]; float hh[16];
#pragma unroll
    for (int grp = 0; grp < 16; ++grp) {
        const int src = (grp & 7) * 8 + es;
        const unsigned xw = (unsigned)__shfl((int)(grp < 8 ? x0 : x1), src); const int e = (int)(xw & 0xffffu); hh[grp] = __uint_as_float(xw & 0xffff0000u);
        w[grp] = *(const u32x4*)(V8s + (size_t)e * 128 + ck * 16);
    }
#pragma unroll
    for (int grp = 0; grp < 16; ++grp) {
        float t[16]; dec16(w[grp], t);
#pragma unroll
        for (int i = 0; i < 16; ++i) acc[i] += hh[grp] * t[i];
        __builtin_amdgcn_sched_barrier(0);
    }
    const bool b5 = (lane & 32) != 0, b4 = (lane & 16) != 0, b3 = (lane & 8) != 0;
    float a8[8], a4[4];
#pragma unroll
    for (int i = 0; i < 8; ++i) { const float keep = b5 ? acc[i + 8] : acc[i], send = b5 ? acc[i] : acc[i + 8]; a8[i] = keep + __shfl_xor(send, 32); }
#pragma unroll
    for (int i = 0; i < 4; ++i) { const float keep = b4 ? a8[i + 4] : a8[i], send = b4 ? a8[i] : a8[i + 4]; a4[i] = keep + __shfl_xor(send, 16); }
#pragma unroll
    for (int i = 0; i < 2; ++i) { const float keep = b3 ? a4[i + 2] : a4[i], send = b3 ? a4[i] : a4[i + 2]; acc2[i] = keep + __shfl_xor(send, 8); }
}
DEVINL void phase_peer_v(const Params& p, int layer, int nrows) {
    typedef float f32x2 __attribute__((ext_vector_type(2)));
    const int lane = threadIdx.x & 63, wid = threadIdx.x >> 6;
    const int k = blockIdx.x & 7, j = blockIdx.x >> 3, nj = gridDim.x >> 3;
    const unsigned char* V8s = tab8(p, layer) + (size_t)16384 * 1024 + (size_t)k * ((size_t)16384 * 128);
    const unsigned* HC = (const unsigned*)(p.ws + WS_R2 + (size_t)33 * MiB);
    bf16_t* XR = (bf16_t*)(p.ws + WS_XR);
    const int col = k * 128 + (lane & 7) * 16 + ((lane & 32) ? 8 : 0) + ((lane & 16) ? 4 : 0) + ((lane & 8) ? 2 : 0);
    if (nj == 0 || j >= nj) return;
    int row = j * 8 + wid;
    unsigned nx0 = 0u, nx1 = 0u;
    if (row < nrows) { nx0 = HC[(size_t)row * 128 + lane]; nx1 = HC[(size_t)row * 128 + 64 + lane]; }
    for (; row < nrows; row += nj * 8) {
        float a2[2];
        const unsigned x0 = nx0, x1 = nx1;
        const int nrow = row + nj * 8;
        if (nrow < nrows) { nx0 = HC[(size_t)nrow * 128 + lane]; nx1 = HC[(size_t)nrow * 128 + 64 + lane]; }
        vslice_token(V8s, lane, x0, x1, a2);
        const f32x2 g2 = *(const f32x2*)(mod_ptr(p, layer, row_bb(row), 5) + col);
        unsigned* xp = (unsigned*)(XR + (size_t)row * DM + col);
        const unsigned x = *xp;
        *xp = pk2(__uint_as_float(x << 16) + g2.x * a2[0], __uint_as_float(x & 0xffff0000u) + g2.y * a2[1]);
    }
}
constexpr int TAIL_SLOTS = 232 + 240 + 224;
constexpr size_t TAB_ITEMS = (size_t)16384 * 1024 / 16;
DEVINL void convert_items(const Params& p, size_t it_lo, size_t it_hi) {
    for (size_t g = it_lo + threadIdx.x; g < it_hi; g += NTHREADS) {
        const int layer = (int)(g / (2 * TAB_ITEMS)); const size_t rem = g % (2 * TAB_ITEMS); const int isv = (int)(rem / TAB_ITEMS); const size_t i = rem % TAB_ITEMS;
        const float* src = (isv ? p.in[21] : p.in[20]) + (size_t)layer * 16384 * 1024 + i * 16; const float scale = isv ? V8_SCALE : U8_SCALE;
        u32x4 o;
#pragma unroll
        for (int q = 0; q < 4; ++q) {
            const f32x4 a = *(const f32x4*)(src + q * 4);
            int w = 0;
            w = __builtin_amdgcn_cvt_pk_fp8_f32(clamp8(a.x * scale), clamp8(a.y * scale), w, false);
            w = __builtin_amdgcn_cvt_pk_fp8_f32(clamp8(a.z * scale), clamp8(a.w * scale), w, true);
            o[q] = (unsigned)w;
        }
        const size_t e = i >> 6; const int c0 = (int)(i & 63) * 16;
        *(u32x4*)(tab8(p, layer) + (size_t)isv * 16384 * 1024 + (size_t)(c0 >> 7) * ((size_t)16384 * 128) + e * 128 + (c0 & 127)) = o;
    }
}
DEVINL void tail_convert(const Params& p, int n_units, int slot_base) {
    if (gridDim.x != 256) return;
    const int rem = n_units % 256;
    if ((int)blockIdx.x < rem) return;
    const int slot = slot_base + (int)blockIdx.x - rem;
    const size_t per = (4 * TAB_ITEMS + TAIL_SLOTS - 1) / TAIL_SLOTS;
    const size_t lo = (size_t)slot * per, hi = lo + per < 4 * TAB_ITEMS ? lo + per : 4 * TAB_ITEMS;
    if (lo < hi) convert_items(p, lo, hi);
}
DEVINL void phase_final_norm(const Params& p) {
    const int lane = threadIdx.x & 63, gw = blockIdx.x * NWAVES + (threadIdx.x >> 6), ngw = gridDim.x * NWAVES;
    const bf16_t* XR = (const bf16_t*)(p.ws + WS_XR);
    u32x2 nvA[4], nvB[4]; f32x4 g[4];
#pragma unroll
    for (int jq = 0; jq < 4; ++jq) g[jq] = *(const f32x4*)(p.in[22] + (jq * 64 + lane) * 4);
    if (gw < TLAT) {
#pragma unroll
        for (int jq = 0; jq < 4; ++jq) nvA[jq] = *(const u32x2*)(XR + (size_t)gw * DM + (jq * 64 + lane) * 4);
    }
    if (gw + ngw < TLAT) {
#pragma unroll
        for (int jq = 0; jq < 4; ++jq) nvB[jq] = *(const u32x2*)(XR + (size_t)(gw + ngw) * DM + (jq * 64 + lane) * 4);
    }
#define FN_PROCESS(row_, nv_, nrow_) do { \
        f32x4 v[4]; float ss = 0.f; \
        _Pragma("unroll") for (int jq = 0; jq < 4; ++jq) { v[jq] = (f32x4){__uint_as_float(nv_[jq].x << 16), __uint_as_float(nv_[jq].x & 0xffff0000u), __uint_as_float(nv_[jq].y << 16), __uint_as_float(nv_[jq].y & 0xffff0000u)}; \
            ss += (v[jq].x * v[jq].x + v[jq].y * v[jq].y) + (v[jq].z * v[jq].z + v[jq].w * v[jq].w); } \
        if ((nrow_) < TLAT) { _Pragma("unroll") for (int jq = 0; jq < 4; ++jq) nv_[jq] = *(const u32x2*)(XR + (size_t)(nrow_) * DM + (jq * 64 + lane) * 4); } \
        const float rinv = rsqrtf(wave_sum(ss) * (1.f / DM) + EPS); \
        _Pragma("unroll") for (int jq = 0; jq < 4; ++jq) *(f32x4*)(p.out + (size_t)(row_) * DM + (jq * 64 + lane) * 4) = v[jq] * rinv * g[jq]; \
    } while (0)
    for (int row = gw; row < TLAT; row += 2 * ngw) {
        FN_PROCESS(row, nvA, row + 2 * ngw);
        if (row + ngw < TLAT) FN_PROCESS(row + ngw, nvB, row + 3 * ngw);
    }
#undef FN_PROCESS
}
constexpr int KEY_LS = 136;
DEVINL void topk_pack32(const u32x4 (&raw)[4], int lq, int (&pv)[32]) {
#pragma unroll
    for (int q = 0; q < 4; ++q)
#pragma unroll
        for (int c = 0; c < 4; ++c) {
            const unsigned w = raw[q][c];
            const int k = lq * 32 + q * 8 + c * 2;
            pv[q * 8 + c * 2] = (int)((w << 16) | (unsigned)k);
            pv[q * 8 + c * 2 + 1] = (int)((w & 0xffff0000u) | (unsigned)(k + 1));
        }
}
DEVINL void phase_topk_scores(const Params& p, int nrows, char* smem) {
    const int tid = threadIdx.x, lane = tid & 63, wid = __builtin_amdgcn_readfirstlane(tid >> 6), l15 = lane & 15, lq = lane >> 4;
    int* scr = (int*)smem + wid * 1056;
    const bf16_t* SC = (const bf16_t*)(p.ws + WS_R4);
    unsigned* GX = (unsigned*)(p.ws + WS_R2);
    const int* pab = topk_pairs_init(smem);
    const int ntask = (nrows / 32) * 8, gw = blockIdx.x * NWAVES + wid, ngw = gridDim.x * NWAVES;
    u32x4 nx[2][4];
#define TS_FETCH(task_, half_) do { const int t0_ = ((task_) >> 3) * 32, h_ = (task_) & 7; \
        _Pragma("unroll") for (int g = 0; g < 2; ++g) { const bf16_t* sp = SC + ((((size_t)((t0_ >> 4) + g) * 16 + (h_ * 2 + (half_))) * 16 + lq * 4) * 16 + l15) * 8; \
            _Pragma("unroll") for (int q = 0; q < 4; ++q) nx[g][q] = *(const u32x4*)(sp + q * 128); } } while (0)
    const int rem = ntask % ngw; const bool even = rem <= (int)gridDim.x;
    const int nfull = even ? ntask / ngw : (gw < ntask ? (ntask - gw + ngw - 1) / ngw : 0);
    const int xtask = (even && (int)blockIdx.x < rem && wid == ((int)blockIdx.x & 7)) ? (ntask / ngw) * ngw + (int)blockIdx.x : -1;
    const int nmine = nfull + (xtask >= 0 ? 1 : 0);
#define TS_TASK(i_) ((i_) < nfull ? gw + (i_) * ngw : xtask)
    if (nmine > 0) TS_FETCH(TS_TASK(0), 0);
    for (int ti = 0; ti < nmine; ++ti) {
        const int task = TS_TASK(ti);
        const int tok0 = (task >> 3) * 32, h = task & 7;
#pragma unroll
        for (int half = 0; half < 2; ++half) {
            u32x4 cur0[4], cur1[4];
#pragma unroll
            for (int q = 0; q < 4; ++q) { cur0[q] = nx[0][q]; cur1[q] = nx[1][q]; }
            if (half == 0) TS_FETCH(task, 1); else if (ti + 1 < nmine) TS_FETCH(TS_TASK(ti + 1), 0);
            int pv0[32], pv1[32], t0[16], t1[16], m[16];
            topk_pack32(cur0, lq, pv0); topk_pack32(cur1, lq, pv1);
            top16_lane(pv0, t0); top16_lane(pv1, t1);
            merge_groups(t0, t1, m);
            if ((lq & 1) == 0) {
                int* dst = scr + (lq >> 1) * 528 + l15 * 33 + half * 16;
#pragma unroll
                for (int r = 0; r < 16; ++r) dst[r] = m[r];
            }
        }
        __builtin_amdgcn_fence(__ATOMIC_RELEASE, "wavefront"); __builtin_amdgcn_wave_barrier(); __builtin_amdgcn_fence(__ATOMIC_ACQUIRE, "wavefront");
        topk_combine2(scr, lane, pab, h, TopkOutGlobal{GX, tok0}, TopkOutGlobal{GX, tok0 + 16});
    }
#undef TS_FETCH
#undef TS_TASK
}
DEVINL void phase_peer_u_sliced(const Params& p, int layer, int nrows) {
    typedef long i64x2 __attribute__((ext_vector_type(2)));
    const int lane = threadIdx.x & 63, wid = threadIdx.x >> 6, l15 = lane & 15, lq = lane >> 4;
    const int k = blockIdx.x & 7, j = blockIdx.x >> 3, nj = gridDim.x >> 3;
    if (nj == 0 || j >= nj) return;
    const int es = l15 >> 1, ck = 2 * lq + (l15 & 1), rep = (lane & 1) + 2 * lq;
    const bool odd = (l15 & 1) != 0;
    const unsigned char* U8s = tab8(p, layer) + (size_t)k * ((size_t)16384 * 128);
    const unsigned char* F8 = (const unsigned char*)p.out + (size_t)32 * MiB + k * 128 + ck * 16;
    const int* EX = (const int*)(p.ws + WS_R2);
    unsigned* PD = (unsigned*)(p.ws + WS_R4) + (size_t)k * ((size_t)TALL * 64);
    const int step = nj * 8;
    int row = j * 8 + wid;
    if (row >= nrows) return;
    int nid0 = EX[(size_t)row * 128 + lane], nid1 = EX[(size_t)row * 128 + 64 + lane];
    typedef unsigned u32x4f __attribute__((ext_vector_type(4)));
    u32x4f nf = (u32x4f){0u, 0u, 0u, 0u};
    if (es == 0) nf = *(const u32x4f*)(F8 + (size_t)row * DM);
#define U_BCAST(x_) do { _Pragma("unroll") for (int d_ = 0; d_ < 4; ++d_) { int t_ = (int)(x_)[d_]; \
        t_ = __builtin_amdgcn_update_dpp(t_, t_, 0x44, 0xF, 0xF, false); t_ = __builtin_amdgcn_update_dpp(t_, t_, 0x114, 0xF, 0xF, false); t_ = __builtin_amdgcn_update_dpp(t_, t_, 0x118, 0xF, 0xF, false); (x_)[d_] = (unsigned)t_; } } while (0)
    for (; row < nrows; row += step) {
        const int id0 = nid0, id1 = nid1; u32x4f fb = nf; U_BCAST(fb); i64x2 fv; fv.x = (long)(((unsigned long)fb.y << 32) | fb.x); fv.y = (long)(((unsigned long)fb.w << 32) | fb.z);
        const int nrow = row + step;
        if (nrow < nrows) { nid0 = EX[(size_t)nrow * 128 + lane]; nid1 = EX[(size_t)nrow * 128 + 64 + lane]; if (es == 0) nf = *(const u32x4f*)(F8 + (size_t)nrow * DM); }
        i64x2 w[16];
#pragma unroll
        for (int g = 0; g < 16; ++g) { const int e = __shfl(g < 8 ? id0 : id1, (g & 7) * 8 + es) & 0xffff; w[g] = *(const i64x2*)(U8s + (size_t)e * 128 + ck * 16); }
        float keep0 = 0.f, keep1 = 0.f;
#pragma unroll
        for (int g = 0; g < 16; ++g) {
            f32x4 acc = (f32x4){0.f, 0.f, 0.f, 0.f};
            acc = __builtin_amdgcn_mfma_f32_16x16x32_fp8_fp8(fv.x, w[g].x, acc, 0, 0, 0);
            acc = __builtin_amdgcn_mfma_f32_16x16x32_fp8_fp8(fv.y, w[g].y, acc, 0, 0, 0);
            float v = odd ? acc[1] : acc[0];
            v += __int_as_float(__builtin_amdgcn_mov_dpp(__float_as_int(v), 0xB1, 0xF, 0xF, true));
            const bool mine = rep == (g & 7);
            if (g < 8) keep0 = mine ? v : keep0; else keep1 = mine ? v : keep1;
        }
        PD[(size_t)row * 64 + rep * 8 + es] = pk2(keep0, keep1);
    }
}
DEVINL void phase_peer_reduce(const Params& p, int nrows) {
    const int lane = threadIdx.x & 63, sg = lane >> 4, l15 = lane & 15, gw = blockIdx.x * NWAVES + (threadIdx.x >> 6), ngw = gridDim.x * NWAVES;
    const unsigned* PD = (const unsigned*)(p.ws + WS_R4); const unsigned* GX = (const unsigned*)(p.ws + WS_R2);
    unsigned* HC = (unsigned*)(p.ws + WS_R2 + (size_t)33 * MiB);
    const float inv = 1.f / (U8_SCALE * F8_SCALE);
    for (int row0 = gw * 4; row0 < nrows; row0 += ngw * 4) {
        const int row = (row0 + sg < nrows) ? row0 + sg : nrows - 1;
        u32x4 a[8];
#pragma unroll
        for (int kk = 0; kk < 8; ++kk) a[kk] = *(const u32x4*)(PD + ((size_t)kk * TALL + row) * 64 + l15 * 4);
        const u32x4 x0 = *(const u32x4*)(GX + (size_t)row * 128 + l15 * 4), x1 = *(const u32x4*)(GX + (size_t)row * 128 + 64 + l15 * 4);
        f32x4 lo = (f32x4){0.f, 0.f, 0.f, 0.f}, hi = lo;
#pragma unroll
        for (int kk = 0; kk < 8; ++kk)
#pragma unroll
            for (int i = 0; i < 4; ++i) { lo[i] += __uint_as_float(a[kk][i] << 16); hi[i] += __uint_as_float(a[kk][i] & 0xffff0000u); }
        u32x4 o0, o1;
#pragma unroll
        for (int i = 0; i < 4; ++i) { o0[i] = pk2(0.f, __uint_as_float(x0[i] & 0xffff0000u) * gelu_f(lo[i] * inv) * (1.f / V8_SCALE)) | (x0[i] & 0xffffu); o1[i] = pk2(0.f, __uint_as_float(x1[i] & 0xffff0000u) * gelu_f(hi[i] * inv) * (1.f / V8_SCALE)) | (x1[i] & 0xffffu); }
        *(u32x4*)(HC + (size_t)row * 128 + l15 * 4) = o0; *(u32x4*)(HC + (size_t)row * 128 + 64 + l15 * 4) = o1;
    }
}

DEVINL float logsig_fast(float x) { return fminf(x, 0.f) - flog(1.f + fexp(-fabsf(x))); }
DEVINL void phase_gla_prep(const Params& p, char* smem) {
    float* sG = (float*)smem;
    float* sTot = sG + 64 * 32;
    const int tid = threadIdx.x, dp = tid & 63, tq = tid >> 6;
    typedef float f32x2 __attribute__((ext_vector_type(2)));
    const float* G = (const float*)(p.ws + WS_G);
    const bf16_t* QK = (const bf16_t*)(p.ws + WS_R3);
    bf16_t* QREL[2] = {(bf16_t*)(p.ws + WS_R1), (bf16_t*)(p.ws + WS_R2)};
    bf16_t* KEND[2] = {(bf16_t*)(p.ws + WS_R1 + SZ_HALF_R), (bf16_t*)(p.ws + WS_R2 + SZ_HALF_R)};
    float* DEND = (float*)(p.ws + WS_DEND);
    const float* gw_ = p.in[14]; const float* gb_ = p.in[15];
    f32x4 ng = (f32x4){0.f, 0.f, 0.f, 0.f}; unsigned nq[8], nk[8];
#define PREP_FETCH(u_) do { const int r0_ = ((u_) >> 2) * 64, ch_ = ((u_) & 3) * 128 + 2 * dp; ng = *(const f32x4*)(G + (size_t)r0_ * 32 + tid * 4); \
        _Pragma("unroll") for (int i = 0; i < 8; ++i) { const size_t row = (size_t)r0_ + tq * 8 + i; nq[i] = *(const unsigned*)(QK + row * 1024 + ch_); nk[i] = *(const unsigned*)(QK + row * 1024 + 512 + ch_); } } while (0)
#pragma unroll
    for (int i = 0; i < 8; ++i) { nq[i] = 0u; nk[i] = 0u; }
    if ((int)blockIdx.x < 528 * 4) PREP_FETCH((int)blockIdx.x);
    for (int u = blockIdx.x; u < 528 * 4; u += gridDim.x) {
        const int cidx = u >> 2, h = u & 3, row0 = cidx * 64, ch = h * 128 + 2 * dp;
        __syncthreads();
        *(f32x4*)(sG + tid * 4) = ng;
        unsigned qraw[8], kraw[8];
#pragma unroll
        for (int i = 0; i < 8; ++i) { qraw[i] = nq[i]; kraw[i] = nk[i]; }
        if (u + (int)gridDim.x < 528 * 4) PREP_FETCH(u + (int)gridDim.x);
        __syncthreads();
        float lg[2][8][2];
#pragma unroll
        for (int dir = 0; dir < 2; ++dir) {
            f32x2 w[16];
#pragma unroll
            for (int j = 0; j < 16; ++j) w[j] = *(const f32x2*)(gw_ + (dir * 16 + j) * 512 + ch);
            const f32x2 bias = *(const f32x2*)(gb_ + dir * 512 + ch);
            float t0 = 0.f, t1 = 0.f;
#pragma unroll
            for (int i = 0; i < 8; ++i) {
                const float* gr = sG + (tq * 8 + i) * 32 + dir * 16;
                f32x2 xv = bias;
#pragma unroll
                for (int j = 0; j < 16; ++j) xv = __builtin_elementwise_fma((f32x2){gr[j], gr[j]}, w[j], xv);
                lg[dir][i][0] = logsig_fast(xv.x) * (1.f / 16.f); lg[dir][i][1] = logsig_fast(xv.y) * (1.f / 16.f);
                t0 += lg[dir][i][0]; t1 += lg[dir][i][1];
            }
            *(f32x2*)(sTot + (dir * 8 + tq) * 128 + 2 * dp) = (f32x2){t0, t1};
        }
        __syncthreads();
#pragma unroll
        for (int dir = 0; dir < 2; ++dir) {
            float be0 = 0.f, be1 = 0.f, r0 = 0.f, r1 = 0.f;
#pragma unroll
            for (int q = 0; q < 8; ++q) {
                const f32x2 t = *(const f32x2*)(sTot + (dir * 8 + q) * 128 + 2 * dp);
                be0 += t.x; be1 += t.y;
                const bool inc = dir == 0 ? (q < tq) : (q > tq);
                r0 += inc ? t.x : 0.f; r1 += inc ? t.y : 0.f;
            }
#pragma unroll
            for (int ii = 0; ii < 8; ++ii) {
                const int i = dir == 0 ? ii : 7 - ii;
                r0 += lg[dir][i][0]; r1 += lg[dir][i][1];
                const size_t row = (size_t)row0 + tq * 8 + i;
                const float q0 = bf2f(qraw[i] & 0xffff), q1 = bf2f(qraw[i] >> 16), k0 = bf2f(kraw[i] & 0xffff), k1 = bf2f(kraw[i] >> 16);
                *(unsigned*)(QREL[dir] + row * 512 + ch) = pk2(q0 * 0.08838834764831845f * fexp(r0 - be0), q1 * 0.08838834764831845f * fexp(r1 - be1));
                *(unsigned*)(KEND[dir] + row * 512 + ch) = pk2(k0 * fexp(be0 - r0), k1 * fexp(be1 - r1));
            }
            if (tq == 0) *(f32x2*)(DEND + ((size_t)dir * 528 + cidx) * 512 + ch) = (f32x2){fexp(be0), fexp(be1)};
        }
    }
#undef PREP_FETCH
}

constexpr int C_QS = 136, C_TS = 72;
#define LDS_BARRIER() do { asm volatile("s_waitcnt lgkmcnt(0)" ::: "memory"); __builtin_amdgcn_s_barrier(); asm volatile("" ::: "memory"); } while (0)
DEVINL void phase_gla_chain(const Params& p, char* smem) {
    constexpr int CH_BUF = (64 * C_QS * 2 + 128 * C_TS + 32 * C_TS) * 2 + 512;
    bf16_t* sSdT = (bf16_t*)(smem + 2 * CH_BUF);
    bf16_t* sP = sSdT + 32 * C_QS;
    const int tid = threadIdx.x, lane = tid & 63, w = tid >> 6, l15 = lane & 15, lq = lane >> 4;
    const bf16_t* VR = (const bf16_t*)(p.ws + WS_R4);
    const float* DEND = (const float*)(p.ws + WS_DEND);
    const int G = gridDim.x, vcu = (G % 8 == 0) ? (blockIdx.x % 8) * (G / 8) + blockIdx.x / 8 : blockIdx.x;
    for (int ch = vcu; ch < 256; ch += G) {
        const int vs = ch & 7, dir = (ch >> 3) & 1, h = (ch >> 4) & 3, b = ch >> 6;
        const bf16_t* QREL = (const bf16_t*)(p.ws + (dir ? WS_R2 : WS_R1));
        const bf16_t* KEND = (const bf16_t*)(p.ws + (dir ? WS_R2 : WS_R1) + SZ_HALF_R);
        bf16_t* OD = dir ? (bf16_t*)((unsigned char*)p.out + (size_t)32 * MiB) : (bf16_t*)(p.ws + WS_R3);
        f32x4 S[2]; S[0] = (f32x4){0.f, 0.f, 0.f, 0.f}; S[1] = S[0];
#define CH_ROW0(n_) ((n_) < 4 ? TLAT + b * CTX + 64 * (dir ? 3 - (n_) : (n_)) : b * SEQ + 64 * (dir ? 127 - ((n_) - 4) : (n_) - 4))
#define CH_LOAD(n_) do { const int r0_ = CH_ROW0(n_);   \
            _Pragma("unroll") for (int i = 0; i < 2; ++i) { const int r = 2 * (tid >> 4) + i, c16 = tid & 15; \
                pq[i] = *(const u32x4*)(QREL + (size_t)(r0_ + r) * 512 + h * 128 + c16 * 8); pk[i] = *(const u32x4*)(KEND + (size_t)(r0_ + r) * 512 + h * 128 + c16 * 8); } \
            if (tid < 128) { _Pragma("unroll") for (int i = 0; i < 2; ++i) pvv[i] = *(const u32x4*)(VR + (size_t)(r0_ + 2 * (tid >> 2) + i) * 2048 + h * 256 + vs * 32 + (tid & 3) * 8); } \
            if (tid < 128) pd = DEND[((size_t)dir * 528 + (r0_ >> 6)) * 512 + h * 128 + tid]; } while (0)
#define CH_PAIR_T(dst_, a_, b_) do {   \
            dst_[0 * (C_TS / 2)] = (a_.x & 0xffffu) | (b_.x << 16); dst_[1 * (C_TS / 2)] = (a_.x >> 16) | (b_.x & 0xffff0000u); \
            dst_[2 * (C_TS / 2)] = (a_.y & 0xffffu) | (b_.y << 16); dst_[3 * (C_TS / 2)] = (a_.y >> 16) | (b_.y & 0xffff0000u); \
            dst_[4 * (C_TS / 2)] = (a_.z & 0xffffu) | (b_.z << 16); dst_[5 * (C_TS / 2)] = (a_.z >> 16) | (b_.z & 0xffff0000u); \
            dst_[6 * (C_TS / 2)] = (a_.w & 0xffffu) | (b_.w << 16); dst_[7 * (C_TS / 2)] = (a_.w >> 16) | (b_.w & 0xffff0000u); } while (0)
#define CH_STAGE(buf_) do { bf16_t* sQ_ = (bf16_t*)(smem + (buf_) * CH_BUF); bf16_t* sK_ = sQ_ + 64 * C_QS; bf16_t* sKT_ = sK_ + 64 * C_QS; bf16_t* sVT_ = sKT_ + 128 * C_TS; float* sD_ = (float*)(sVT_ + 32 * C_TS); \
            { const int r = 2 * (tid >> 4), c16 = tid & 15; \
                _Pragma("unroll") for (int i = 0; i < 2; ++i) { *(u32x4*)(sQ_ + (r + i) * C_QS + c16 * 8) = pq[i]; *(u32x4*)(sK_ + (r + i) * C_QS + c16 * 8) = pk[i]; } \
                unsigned* kt = (unsigned*)(sKT_ + (c16 * 8) * C_TS + ((((r >> 3) ^ (c16 & 7)) << 3) | (r & 7)));       \
                const u32x4 ka_ = pk[0], kb_ = pk[1]; CH_PAIR_T(kt, ka_, kb_); } \
            if (tid < 128) { const int r = 2 * (tid >> 2), c = tid & 3; unsigned* vt = (unsigned*)(sVT_ + (c * 8) * C_TS + ((((r >> 3) ^ c) << 3) | (r & 7))); \
                const u32x4 va_ = pvv[0], vb_ = pvv[1]; CH_PAIR_T(vt, va_, vb_); } \
            if (tid < 128) sD_[tid] = pd; } while (0)
        u32x4 pq[2], pk[2], pvv[2] = {(u32x4){0u, 0u, 0u, 0u}, (u32x4){0u, 0u, 0u, 0u}}; float pd = 0.f;
        LDS_BARRIER();
        CH_LOAD(0); CH_STAGE(0); CH_LOAD(1);
        LDS_BARRIER();
        for (int n = 0; n < 132; ++n) {
            const int row0 = CH_ROW0(n); const bool lat = n >= 4;
            const bf16_t* sQ = (const bf16_t*)(smem + (n & 1) * CH_BUF); const bf16_t* sK = sQ + 64 * C_QS; const bf16_t* sKT = sK + 64 * C_QS; const bf16_t* sVT = sKT + 128 * C_TS; const float* sD = (const float*)(sVT + 32 * C_TS);
            const int ct = w >> 1, ntw = w & 1;
            {
                const f32x4 dv = *(const f32x4*)(sD + 16 * w + lq * 4);
#pragma unroll
                for (int nt = 0; nt < 2; ++nt) {
                    S[nt] = S[nt] * dv;
                    u32x2 o; o.x = pk2(S[nt].x, S[nt].y); o.y = pk2(S[nt].z, S[nt].w);
                    *(u32x2*)(sSdT + (nt * 16 + l15) * C_QS + 16 * w + lq * 4) = o;
                }
            }
            bf16x8 qf[4];
#pragma unroll
            for (int kk = 0; kk < 4; ++kk) qf[kk] = *(const bf16x8*)(sQ + (ct * 16 + l15) * C_QS + kk * 32 + lq * 8);
#pragma unroll
            for (int si = 0; si < 2; ++si) {
                const int st = 2 * ntw + si;
                f32x4 a = (f32x4){0.f, 0.f, 0.f, 0.f};
#pragma unroll
                for (int kk = 0; kk < 4; ++kk) {
                    const bf16x8 ka = *(const bf16x8*)(sK + (st * 16 + l15) * C_QS + kk * 32 + lq * 8);
                    a = __builtin_amdgcn_mfma_f32_16x16x32_bf16(ka, qf[kk], a, 0, 0, 0);
                }
                const int c = ct * 16 + l15, s0 = st * 16 + lq * 4;
                float pv[4];
#pragma unroll
                for (int j = 0; j < 4; ++j) { const int sx = s0 + j; const bool keep = dir ? (sx >= c) : (sx <= c); pv[j] = keep ? a[j] : 0.f; }
                u32x2 o; o.x = pk2(pv[0], pv[1]); o.y = pk2(pv[2], pv[3]);
                *(u32x2*)(sP + c * C_TS + s0) = o;
            }
            LDS_BARRIER();
            bf16x8 vf[2];
#pragma unroll
            for (int ss = 0; ss < 2; ++ss) vf[ss] = *(const bf16x8*)(sVT + (ntw * 16 + l15) * C_TS + (((ss * 4 + lq) ^ ((2 * ntw + (l15 >> 3)) & 3)) << 3));
            {
                f32x4 a = (f32x4){0.f, 0.f, 0.f, 0.f};
#pragma unroll
                for (int ss = 0; ss < 2; ++ss) {
                    const bf16x8 pb = *(const bf16x8*)(sP + (ct * 16 + l15) * C_TS + ss * 32 + lq * 8);
                    a = __builtin_amdgcn_mfma_f32_16x16x32_bf16(vf[ss], pb, a, 0, 0, 0);
                }
#pragma unroll
                for (int kk = 0; kk < 4; ++kk) {
                    const bf16x8 sa = *(const bf16x8*)(sSdT + (ntw * 16 + l15) * C_QS + kk * 32 + lq * 8);
                    a = __builtin_amdgcn_mfma_f32_16x16x32_bf16(sa, qf[kk], a, 0, 0, 0);
                }
                if (lat) {
                    u32x2 o; o.x = pk2(a.x, a.y); o.y = pk2(a.z, a.w);
                    *(u32x2*)(OD + (size_t)(row0 + ct * 16 + l15) * 1024 + h * 256 + vs * 32 + ntw * 16 + lq * 4) = o;
                }
            }
            {
                bf16x8 kf[2];
#pragma unroll
                for (int ss = 0; ss < 2; ++ss) kf[ss] = *(const bf16x8*)(sKT + (16 * w + l15) * C_TS + (((ss * 4 + lq) ^ ((2 * w + (l15 >> 3)) & 7)) << 3));
#pragma unroll
                for (int nt = 0; nt < 2; ++nt)
#pragma unroll
                    for (int ss = 0; ss < 2; ++ss) {
                        const bf16x8 vb = (nt == ntw) ? vf[ss] : *(const bf16x8*)(sVT + (nt * 16 + l15) * C_TS + (((ss * 4 + lq) ^ ((2 * nt + (l15 >> 3)) & 3)) << 3));
                        S[nt] = __builtin_amdgcn_mfma_f32_16x16x32_bf16(kf[ss], vb, S[nt], 0, 0, 0);
                    }
            }
            if (n + 1 < 132) { CH_STAGE((n + 1) & 1); if (n + 2 < 132) CH_LOAD(n + 2); }
            LDS_BARRIER();
        }
    }
}
#undef CH_STAGE
#undef CH_PAIR_T
#undef CH_ROW0
#undef CH_LOAD
DEVINL void phase_gla_post(const Params& p) {
    const int lane = threadIdx.x & 63, gw = blockIdx.x * NWAVES + (threadIdx.x >> 6), ngw = gridDim.x * NWAVES;
    const bf16_t* OF = (const bf16_t*)(p.ws + WS_R3); const bf16_t* OB = (const bf16_t*)((const unsigned char*)p.out + (size_t)32 * MiB);
    const bf16_t* VR = (const bf16_t*)(p.ws + WS_R4);
    unsigned char* Y = p.ws + WS_R1;
    const f32x4 hg = *(const f32x4*)(p.in[16] + lane * 4);
    u32x2 ba[3][4], bb[3][4], br[3][4];
#define POST_FETCH(q_, r_) do { _Pragma("unroll") for (int h = 0; h < 4; ++h) { const int c = h * 256 + lane * 4; ba[q_][h] = *(const u32x2*)(OF + (size_t)(r_) * 1024 + c); bb[q_][h] = *(const u32x2*)(OB + (size_t)(r_) * 1024 + c); \
        br[q_][h] = *(const u32x2*)(VR + (size_t)(r_) * 2048 + 1024 + c); } } while (0)
#pragma unroll
    for (int q = 0; q < 3; ++q) { if (gw + q * ngw < TLAT) POST_FETCH(q, gw + q * ngw); }
    for (int row3 = gw; row3 < TLAT; row3 += 3 * ngw) {
#pragma unroll
      for (int q = 0; q < 3; ++q) {
        const int row = row3 + q * ngw;
        if (row >= TLAT) break;
        u32x2 xa[4], xb[4], xr[4];
#pragma unroll
        for (int h = 0; h < 4; ++h) { xa[h] = ba[q][h]; xb[h] = bb[q][h]; xr[h] = br[q][h]; }
        if (row + 3 * ngw < TLAT) POST_FETCH(q, row + 3 * ngw);
#pragma unroll
        for (int h = 0; h < 4; ++h) {
            const int c = h * 256 + lane * 4;
            const u32x2 a = xa[h], b = xb[h], r = xr[h];
            const float o0 = bf2f(a.x & 0xffff) + bf2f(b.x & 0xffff), o1 = bf2f(a.x >> 16) + bf2f(b.x >> 16), o2 = bf2f(a.y & 0xffff) + bf2f(b.y & 0xffff), o3 = bf2f(a.y >> 16) + bf2f(b.y >> 16);
            const float rinv = rsqrtf(wave_sum((o0 * o0 + o1 * o1) + (o2 * o2 + o3 * o3)) * (1.f / 256.f) + EPS);
#define Y8C(v_) fminf(fmaxf((v_) * Y8_SCALE, -448.f), 448.f)
            int y = 0; y = __builtin_amdgcn_cvt_pk_fp8_f32(Y8C(o0 * rinv * hg.x * silu_f(bf2f(r.x & 0xffff))), Y8C(o1 * rinv * hg.y * silu_f(bf2f(r.x >> 16))), y, false);
            y = __builtin_amdgcn_cvt_pk_fp8_f32(Y8C(o2 * rinv * hg.z * silu_f(bf2f(r.y & 0xffff))), Y8C(o3 * rinv * hg.w * silu_f(bf2f(r.y >> 16))), y, true);
#undef Y8C
            *(int*)(Y + (size_t)row * 1024 + c) = y;
        }
      }
    }
#undef POST_FETCH
}

#define GAS __attribute__((address_space(1)))
#define LAS __attribute__((address_space(3)))
#define XB_TMO      128
#define XB_XCNT(j)  (256  + 64 * (j))
#define XB_XSUB(j)  (1280 + 64 * (j))
#define XB_XGEN(j)  (2304 + 64 * (j))
#define XB_TOP      3328
#define XB_TOPGEN   3392
#define XCD_BAR_WORDS 3456
#define XB_SPIN_CAP (1u << 18)

__device__ __forceinline__ unsigned xb_ld(unsigned* p)              { return __hip_atomic_load(p, __ATOMIC_RELAXED, __HIP_MEMORY_SCOPE_AGENT); }
__device__ __forceinline__ unsigned xb_add(unsigned* p, unsigned v) { return __hip_atomic_fetch_add(p, v, __ATOMIC_RELAXED, __HIP_MEMORY_SCOPE_AGENT); }
__device__ __forceinline__ unsigned xb_xcc_id() { return (unsigned)__builtin_amdgcn_s_getreg((3 << 11) | 20) & 0xFu; }
#define XB_SPIN(cond, bar) do { unsigned _sp = 0; while (cond) { __builtin_amdgcn_s_sleep(1); \
    if ((++_sp & 255u) == 0u) { if (xb_ld(&(bar)[XB_TMO])) break; if (_sp > XB_SPIN_CAP) { atomicAdd(&(bar)[XB_TMO], 1u); break; } } } } while (0)

struct XcdBarrier {
    unsigned* bar; unsigned x;
    volatile LAS unsigned* st;
};

__device__ __forceinline__ XcdBarrier xcd_barrier_post(unsigned* bar, volatile LAS unsigned* st) {
    XcdBarrier b; b.bar = bar; b.x = xb_xcc_id(); b.st = st;
    if (threadIdx.x == 0) (void)xb_add(&bar[XB_XCNT(b.x)], 1u);
    return b;
}
__device__ __forceinline__ void xcd_barrier_complete(unsigned* bar, unsigned x, unsigned& nloc, unsigned& nx) {
    const unsigned G = gridDim.x * gridDim.y * gridDim.z;
    unsigned sum, cnt, mine, sp = 0u;
    for (;;) {
        sum = 0u; cnt = 0u; mine = 0u;
#pragma unroll
        for (unsigned j = 0; j < 16; ++j) { const unsigned c = xb_ld(&bar[XB_XCNT(j)]); sum += c; cnt += (c > 0u) ? 1u : 0u; mine = (j == x) ? c : mine; }
        if (sum == G) break;
        __builtin_amdgcn_s_sleep(1);
        if ((++sp & 255u) == 0u) { if (xb_ld(&bar[XB_TMO])) break; if (sp > XB_SPIN_CAP) { atomicAdd(&bar[XB_TMO], 1u); break; } }
    }
    nloc = mine > 0u ? mine : 1u; nx = cnt > 0u ? cnt : 1u;
}

__device__ __forceinline__ void xcd_barrier(const XcdBarrier& b) {
    asm volatile("s_waitcnt vmcnt(0)" ::: "memory");
    __syncthreads();
    if (threadIdx.x == 0) {
        unsigned* bar = b.bar;
        __builtin_amdgcn_s_waitcnt(0);
        unsigned nloc = b.st[0], nx = b.st[1];
        if (nloc == 0u) { xcd_barrier_complete(bar, b.x, nloc, nx); b.st[0] = nloc; b.st[1] = nx; }
        const unsigned old = xb_add(&bar[XB_XSUB(b.x)], 1u);
        const unsigned gen = old / nloc;
        if (old + 1u == (gen + 1u) * nloc) {
            __builtin_amdgcn_fence(__ATOMIC_RELEASE, "agent");
            asm volatile("s_waitcnt vmcnt(0)" ::: "memory");
            const unsigned og = xb_add(&bar[XB_TOP], 1u);
            const unsigned tg = og / nx;
            if (og + 1u == (tg + 1u) * nx) xb_add(&bar[XB_TOPGEN], 1u);
            else XB_SPIN(xb_ld(&bar[XB_TOPGEN]) == tg, bar);
            __builtin_amdgcn_fence(__ATOMIC_ACQUIRE, "agent");
            xb_add(&bar[XB_XGEN(b.x)], 1u);
            asm volatile("s_waitcnt vmcnt(0)" ::: "memory");
        } else {
            XB_SPIN(xb_ld(&bar[XB_XGEN(b.x)]) == gen, bar);
            __builtin_amdgcn_fence(__ATOMIC_ACQUIRE, "agent");
            asm volatile("s_waitcnt vmcnt(0)" ::: "memory");
        }
    }
    __syncthreads();
}
constexpr size_t WS_BAR = 64 * 1024;
constexpr size_t CTL_ZERO_BYTES = 128 * 1024;
constexpr int LDS_MISC_OFF = LDS_BYTES - 64;

#define GEMM_RUN(EPI, EOBJ, Aptr, Bptr, M_, N_) do { pg8::Gemm g_{(const pg8::bf16_t*)(Aptr), (const pg8::bf16_t*)(Bptr), (M_), (N_), DM}; pg8::StaticOrder S_; S_.init((M_), (N_), (int)gridDim.x, (int)blockIdx.x); \
        const EPI E_ = EOBJ; pg8::gemm_phase<EPI, pg8::StaticOrder, true, true>((PG8_LAS unsigned char*)smem, g_, S_, E_); } while (0)
#define GEMM_RUN8(EPI, EOBJ, Aptr, Bptr, M_, N_) do { pg8::Gemm g_{(const pg8::bf16_t*)(Aptr), (const pg8::bf16_t*)(Bptr), (M_), (N_), DM / 2}; pg8::StaticOrder S_; S_.init((M_), (N_), (int)gridDim.x, (int)blockIdx.x); \
        const EPI E_ = EOBJ; pg8::gemm_phase<EPI, pg8::StaticOrder, true, true, true>((PG8_LAS unsigned char*)smem, g_, S_, E_); } while (0)
DEVINL void run_phase(const Params& p, int ph, char* smem) {
    unsigned char* ws = p.ws;
#ifdef ONLY_PHASE
    ph = ONLY_PHASE;
#endif
    switch (ph) {
    case 0: phase_prologue(p, smem);
            if (gridDim.x != 256) { const size_t per = (4 * TAB_ITEMS + gridDim.x - 1) / gridDim.x, lo = blockIdx.x * per, hi = lo + per < 4 * TAB_ITEMS ? lo + per : 4 * TAB_ITEMS; if (lo < hi) convert_items(p, lo, hi); }
            break;
    case 1: phase_norm_mod(p, p.in[0], p.in[2], TALL, p.in[6], 0, 0, 1, nullptr, ws + WS_R1); break;
    case 2: GEMM_RUN8(pg8::EpiStoreBf16, (pg8::EpiStoreBf16{(bf16_t*)(ws + WS_R4), ATTN_IN, 1.f / (F8_SCALE * W8_SCALE)}), ws + WS_R1, ws + WS_WT_ATTN_IN, TALL, ATTN_IN); tail_convert(p, (TALL / 256) * (ATTN_IN / 256), 0); break;
    case 3: phase_qkpost(p); break;
    case 4: phase_attn(p, smem); break;
    case 5: GEMM_RUN8(pg8::EpiResid<false>, (pg8::EpiResid<false>{p.in[0], p.in[2], (bf16_t*)(ws + WS_XR), mod_ptr(p, 0, 0, 2), 1.f / (O8_SCALE * W8_SCALE)}), ws + WS_R4, ws + WS_WT_ATTN_OUT, TALL, DM); tail_convert(p, (TALL / 256) * (DM / 256), 232); break;
    case 6: phase_norm_mod<true>(p, ws + WS_XR, (const bf16_t*)(ws + WS_XR) + (size_t)TLAT * DM, TALL, p.in[7], 0, 3, 4, nullptr, (unsigned char*)p.out + (size_t)32 * MiB);
            break;
    case 7: GEMM_RUN8(pg8::EpiStoreKeys, (pg8::EpiStoreKeys{(bf16_t*)(ws + WS_R4), 2048, 1.f / (F8_SCALE * W8_SCALE)}), (unsigned char*)p.out + (size_t)32 * MiB, ws + WS_WT_PQ0, TALL, 2048); tail_convert(p, (TALL / 256) * (2048 / 256), 472); break;
    case 8: break;
    case 9: phase_topk_scores(p, TALL, smem); break;
    case 25: phase_peer_u_sliced(p, 0, TALL); break;
    case 26: phase_peer_reduce(p, TALL); break;
    case 19: phase_peer_v(p, 0, TALL); break;
    case 20: phase_norm_mod<true>(p, ws + WS_XR, (const bf16_t*)(ws + WS_XR) + (size_t)TLAT * DM, TALL, p.in[6] + 1024, 1, 0, 1, nullptr, ws + WS_R1); break;
    case 10: GEMM_RUN8(pg8::EpiGla, (pg8::EpiGla{(bf16_t*)(ws + WS_R3), (bf16_t*)(ws + WS_R4), (float*)(ws + WS_G), 1.f / (F8_SCALE * W8_SCALE)}), ws + WS_R1, ws + WS_WT_GLA_IN, TALL, GLA_IN_PAD); break;
    case 11: phase_gla_prep(p, smem); break;
    case 12: phase_gla_chain(p, smem); break;
    case 13: phase_gla_post(p); break;
    case 14: GEMM_RUN8(pg8::EpiResid<true>, (pg8::EpiResid<true>{(const bf16_t*)(ws + WS_XR), (const bf16_t*)(ws + WS_XR) + (size_t)TLAT * DM, (bf16_t*)(ws + WS_XR), mod_ptr(p, 1, 0, 2), 1.f / (Y8_SCALE * W8_SCALE)}), ws + WS_R1, ws + WS_WT_GLA_OUT, TLAT, DM); break;
    case 15: phase_norm_mod<true>(p, ws + WS_XR, (const bf16_t*)(ws + WS_XR) + (size_t)TLAT * DM, TLAT, p.in[7] + 1024, 1, 3, 4, nullptr, (unsigned char*)p.out + (size_t)32 * MiB);
             break;
    case 16: GEMM_RUN8(pg8::EpiStoreKeys, (pg8::EpiStoreKeys{(bf16_t*)(ws + WS_R4), 2048, 1.f / (F8_SCALE * W8_SCALE)}), (unsigned char*)p.out + (size_t)32 * MiB, ws + WS_WT_PQ1, TLAT, 2048); break;
    case 17: break;
    case 18: phase_topk_scores(p, TLAT, smem); break;
    case 27: phase_peer_u_sliced(p, 1, TLAT); break;
    case 28: phase_peer_reduce(p, TLAT); break;
    case 21: phase_peer_v(p, 1, TLAT); break;
    case 22: phase_final_norm(p); break;
    default: break;
    }
}

__global__ void __launch_bounds__(NTHREADS, 2) fwd_kernel(Params p, int ph_lo, int ph_hi) {
    extern __shared__ __attribute__((aligned(16))) char smem[];
    cg::grid_group grid = cg::this_grid();
    volatile LAS unsigned* misc = (volatile LAS unsigned*)((LAS unsigned char*)smem + LDS_MISC_OFF);
    if (threadIdx.x < 2) misc[threadIdx.x] = 0u;
    __syncthreads();
    (void)xcd_barrier_post((unsigned*)(p.ws + WS_BAR), misc);
#ifndef PROBE_MASK
#define PROBE_MASK 0u
#endif
#define SEAM(k) do { if ((k) == 0) grid.sync(); else { XcdBarrier xb_; xb_.bar = (unsigned*)(p.ws + WS_BAR); xb_.x = xb_xcc_id(); xb_.st = (volatile LAS unsigned*)((LAS unsigned char*)smem + LDS_MISC_OFF); xcd_barrier(xb_); } } while (0)
#define PHASE(k) if (ph_lo <= (k) && (k) < ph_hi) { run_phase(p, (k), smem); if ((PROBE_MASK >> (k)) & 1u) { SEAM(k); run_phase(p, (k), smem); } SEAM(k); }
    PHASE(0) PHASE(1) PHASE(2) PHASE(3) PHASE(4) PHASE(5) PHASE(6) PHASE(7) PHASE(9) PHASE(25) PHASE(26) PHASE(19) PHASE(20)
    PHASE(10) PHASE(11) PHASE(12) PHASE(13) PHASE(14) PHASE(15) PHASE(16) PHASE(18) PHASE(27) PHASE(28) PHASE(21)
    if (ph_lo <= 22 && 22 < ph_hi) run_phase(p, 22, smem);
#undef PHASE
#undef SEAM
}

extern "C" void kernel_launch(void* const* d_in, const int* in_sizes, int n_in, void* d_out, int out_size, void* d_ws, size_t ws_size, hipStream_t stream) {
    static int grid = 0;
    if (grid == 0) {
        if (n_in != 23 || ws_size < WS_END || out_size != TLAT * DM) { fprintf(stderr, "kernel_launch: unexpected problem (n_in %d, ws %zu, out %d)\n", n_in, ws_size, out_size); grid = -1; return; }
        int dev = 0, cus = 0, per_cu = 0;
        hipGetDevice(&dev);
        hipDeviceGetAttribute(&cus, hipDeviceAttributeMultiprocessorCount, dev);
        hipFuncSetAttribute((const void*)fwd_kernel, hipFuncAttributeMaxDynamicSharedMemorySize, LDS_BYTES);
        hipOccupancyMaxActiveBlocksPerMultiprocessor(&per_cu, (const void*)fwd_kernel, NTHREADS, LDS_BYTES);
        if (per_cu < 1) { fprintf(stderr, "kernel_launch: occupancy query says %d blocks per CU\n", per_cu); grid = -1; return; }
        if (per_cu > 2) per_cu = 2;
        grid = cus * per_cu;
        fprintf(stderr, "kernel_launch: grid %d (%d per CU), ws %zu\n", grid, per_cu, ws_size);
    }
    if (grid < 0) return;
    Params p{};
    for (int i = 0; i < 23; ++i) p.in[i] = (const float*)d_in[i];
    p.out = (float*)d_out; p.ws = (unsigned char*)d_ws;
    if (hipMemsetAsync(d_ws, 0, CTL_ZERO_BYTES, stream) != hipSuccess) { fprintf(stderr, "kernel_launch: memset of control words failed\n"); return; }
    int lo = 0, hi = 1000;
    void* args[] = {&p, &lo, &hi};
    hipError_t e = hipLaunchCooperativeKernel((const void*)fwd_kernel, dim3(grid), dim3(NTHREADS), args, LDS_BYTES, stream);
    if (e != hipSuccess) fprintf(stderr, "cooperative launch failed: %s (grid %d)\n", hipGetErrorString(e), grid);
}
```
